# Optimizing an MI355X kernel written in HIP

```python
import math
import jax, jax.numpy as jnp
from jax import lax
import numpy as np

D_MODEL = 2048
BATCH = 4
SEQ = 4096
DEPTH = 2

CHUNK = 64
N_LEFT_CHUNKS = 8
BAND = (N_LEFT_CHUNKS + 1) * CHUNK

A_HEADS = 16
A_HEAD_DIM = 64
A_WIDTH = A_HEADS * A_HEAD_DIM
MAX_REL = 128
N_REL = 2 * MAX_REL + 1

S5_WIDTH = D_MODEL // 2
S5_GROUP = 16
S5_GROUPS = S5_WIDTH // S5_GROUP
S5_STATE = 64
DT_MIN = 0.001
DT_MAX = 0.1

C_HEADS = 16
C_HEAD_DIM = 128
C_WIDTH = C_HEADS * C_HEAD_DIM
Q_BLOCK = 128

EVEN_MIX = A_WIDTH + S5_WIDTH
W_IN_EVEN = 3 * A_WIDTH + S5_WIDTH + A_WIDTH + S5_WIDTH
W_IN_ODD = 3 * C_WIDTH + C_WIDTH + C_HEADS
N_EVEN = (DEPTH + 1) // 2
N_ODD = DEPTH // 2
EPS = 1e-6

kernel_name = "hybrid_chunked_attn_s5_fox_encoder"


def rmsnorm(x, g):
    xf = x.astype(jnp.float32)
    y = xf * lax.rsqrt(jnp.mean(xf * xf, axis=-1, keepdims=True) + EPS)
    return (y * g.astype(jnp.float32)).astype(x.dtype)


def chunked_relpos_attention(q, k, v, rel_bias):
    b, l, h, dh = q.shape
    nc = l // CHUNK
    qc = q.reshape(b, nc, CHUNK, h, dh)
    pad = ((0, 0), (N_LEFT_CHUNKS, 0), (0, 0), (0, 0), (0, 0))
    kc = jnp.pad(k.reshape(b, nc, CHUNK, h, dh), pad)
    vc = jnp.pad(v.reshape(b, nc, CHUNK, h, dh), pad)
    band_idx = jnp.arange(nc)[:, None] + jnp.arange(N_LEFT_CHUNKS + 1)[None, :]
    kb = jnp.take(kc, band_idx, axis=1).reshape(b, nc, BAND, h, dh)
    vb = jnp.take(vc, band_idx, axis=1).reshape(b, nc, BAND, h, dh)
    scale = 1.0 / math.sqrt(dh)
    s = jnp.einsum('bcqhd,bckhd->bhcqk', qc, kb).astype(jnp.float32) * scale
    rel = jnp.arange(CHUNK)[:, None] + N_LEFT_CHUNKS * CHUNK - jnp.arange(BAND)[None, :]
    rel_idx = jnp.clip(rel, -MAX_REL, MAX_REL) + MAX_REL
    bias = rel_bias.astype(jnp.float32)[:, rel_idx]
    key_chunk = jnp.arange(nc)[:, None] - N_LEFT_CHUNKS + jnp.arange(BAND)[None, :] // CHUNK
    valid = key_chunk >= 0
    s = s + bias[None, :, None]
    s = jnp.where(valid[None, None, :, None, :], s, -jnp.inf)
    p = jax.nn.softmax(s, axis=-1).astype(v.dtype)
    o = jnp.einsum('bhcqk,bckhd->bcqhd', p, vb)
    return o.reshape(b, l, h * dh)


def s5_ssm(u, lam_re, lam_im, log_dt, b_re, b_im, c_re, c_im, d_skip):
    bsz, l, _ = u.shape
    uf = u.astype(jnp.float32).reshape(bsz, l, S5_GROUPS, S5_GROUP)
    lr = lam_re.astype(jnp.float32)
    li = lam_im.astype(jnp.float32)
    dt = jnp.exp(log_dt.astype(jnp.float32))[:, None]
    mag = jnp.exp(lr * dt)
    ang = li * dt
    a_re = mag * jnp.cos(ang)
    a_im = mag * jnp.sin(ang)
    den = lr * lr + li * li
    nr = a_re - 1.0
    ni = a_im
    coef_re = (nr * lr + ni * li) / den
    coef_im = (ni * lr - nr * li) / den
    br = b_re.astype(jnp.float32)
    bi = b_im.astype(jnp.float32)
    bb_re = coef_re[..., None] * br - coef_im[..., None] * bi
    bb_im = coef_re[..., None] * bi + coef_im[..., None] * br
    bu_re = jnp.einsum('blgc,gpc->blgp', uf, bb_re)
    bu_im = jnp.einsum('blgc,gpc->blgp', uf, bb_im)
    a_re_t = jnp.broadcast_to(a_re, (1, l, S5_GROUPS, S5_STATE))
    a_im_t = jnp.broadcast_to(a_im, (1, l, S5_GROUPS, S5_STATE))

    def combine(e1, e2):
        ar1, ai1, xr1, xi1 = e1
        ar2, ai2, xr2, xi2 = e2
        return (ar2 * ar1 - ai2 * ai1,
                ar2 * ai1 + ai2 * ar1,
                ar2 * xr1 - ai2 * xi1 + xr2,
                ar2 * xi1 + ai2 * xr1 + xi2)

    _, _, xr, xi = lax.associative_scan(combine, (a_re_t, a_im_t, bu_re, bu_im), axis=1)
    y = (jnp.einsum('blgp,gcp->blgc', xr, c_re.astype(jnp.float32))
         - jnp.einsum('blgp,gcp->blgc', xi, c_im.astype(jnp.float32))
         + d_skip.astype(jnp.float32) * uf)
    return y.reshape(bsz, l, S5_WIDTH)


def forgetting_attention(q, k, v, log_f):
    b, l, h, dh = q.shape
    nqb = l // Q_BLOCK
    cum = jnp.cumsum(log_f, axis=1).transpose(0, 2, 1)
    qb = q.reshape(b, nqb, Q_BLOCK, h, dh).transpose(1, 0, 3, 2, 4)
    cq = cum.reshape(b, h, nqb, Q_BLOCK).transpose(2, 0, 1, 3)
    kpos = jnp.arange(l)
    scale = 1.0 / math.sqrt(dh)

    def block(args):
        qi, cqi, bi = args
        s = jnp.einsum('bhqd,bkhd->bhqk', qi, k).astype(jnp.float32) * scale
        s = s + cqi[..., None] - cum[:, :, None, :]
        qpos = bi * Q_BLOCK + jnp.arange(Q_BLOCK)
        s = jnp.where(kpos[None, :] <= qpos[:, None], s, -jnp.inf)
        p = jax.nn.softmax(s, axis=-1).astype(v.dtype)
        return jnp.einsum('bhqk,bkhd->bqhd', p, v)

    o = lax.map(block, (qb, cq, jnp.arange(nqb)))
    return o.transpose(1, 0, 2, 3, 4).reshape(b, l, h * dh)


def even_layer(x, norm_g, w_in, rel_bias, lam_re, lam_im, log_dt, b_re, b_im,
               c_re, c_im, d_skip, w_glu, b_glu, w_out):
    bsz, l, _ = x.shape
    hn = rmsnorm(x, norm_g)
    proj = hn @ w_in
    cuts = [A_WIDTH, 2 * A_WIDTH, 3 * A_WIDTH, 3 * A_WIDTH + S5_WIDTH,
            4 * A_WIDTH + S5_WIDTH]
    q, k, v, u, z_a, z_b = jnp.split(proj, cuts, axis=-1)
    shp = (bsz, l, A_HEADS, A_HEAD_DIM)
    o_a = chunked_relpos_attention(q.reshape(shp), k.reshape(shp), v.reshape(shp), rel_bias)
    o_a = o_a * jax.nn.silu(z_a)
    y = jax.nn.gelu(s5_ssm(u, lam_re, lam_im, log_dt, b_re, b_im, c_re, c_im, d_skip).astype(x.dtype))
    o_b = y * jax.nn.sigmoid(y @ w_glu + b_glu)
    o_b = o_b * jax.nn.silu(z_b)
    return x + jnp.concatenate([o_a, o_b], axis=-1) @ w_out


def odd_layer(x, norm_g, w_in, b_forget, w_out):
    bsz, l, _ = x.shape
    hn = rmsnorm(x, norm_g)
    proj = hn @ w_in
    cuts = [C_WIDTH, 2 * C_WIDTH, 3 * C_WIDTH, 4 * C_WIDTH]
    q, k, v, z, f_logit = jnp.split(proj, cuts, axis=-1)
    log_f = jax.nn.log_sigmoid((f_logit + b_forget).astype(jnp.float32))
    shp = (bsz, l, C_HEADS, C_HEAD_DIM)
    o = forgetting_attention(q.reshape(shp), k.reshape(shp), v.reshape(shp), log_f)
    o = o * jax.nn.silu(z)
    return x + o @ w_out


def setup_inputs(seed: int = 0) -> dict:
    key = jax.random.key(seed)
    ks = jax.random.split(key, 20)
    f32 = jnp.float32
    x = jax.random.normal(ks[0], (BATCH, SEQ, D_MODEL), f32)
    norm_even_g = 1.0 + 0.05 * jax.random.normal(ks[1], (N_EVEN, D_MODEL), f32)
    w_in_even = jax.random.normal(ks[2], (N_EVEN, D_MODEL, W_IN_EVEN), f32) * D_MODEL ** -0.5
    rel_bias = 0.2 * jax.random.normal(ks[3], (N_EVEN, A_HEADS, N_REL), f32)
    n = jnp.arange(S5_STATE, dtype=f32)
    s5_lambda_re = -0.5 + 0.01 * jax.random.normal(ks[4], (N_EVEN, S5_GROUPS, S5_STATE), f32)
    s5_lambda_im = math.pi * n + 0.01 * jax.random.normal(ks[5], (N_EVEN, S5_GROUPS, S5_STATE), f32)
    s5_log_dt = jax.random.uniform(ks[6], (N_EVEN, S5_GROUPS), f32,
                                   math.log(DT_MIN), math.log(DT_MAX))
    s5_b_re = jax.random.normal(ks[7], (N_EVEN, S5_GROUPS, S5_STATE, S5_GROUP), f32) * (2 * S5_GROUP) ** -0.5
    s5_b_im = jax.random.normal(ks[8], (N_EVEN, S5_GROUPS, S5_STATE, S5_GROUP), f32) * (2 * S5_GROUP) ** -0.5
    s5_c_re = jax.random.normal(ks[9], (N_EVEN, S5_GROUPS, S5_GROUP, S5_STATE), f32) * (2 * S5_STATE) ** -0.5
    s5_c_im = jax.random.normal(ks[10], (N_EVEN, S5_GROUPS, S5_GROUP, S5_STATE), f32) * (2 * S5_STATE) ** -0.5
    s5_d = 0.5 * jax.random.normal(ks[11], (N_EVEN, S5_GROUPS, S5_GROUP), f32)
    w_glu = jax.random.normal(ks[12], (N_EVEN, S5_WIDTH, S5_WIDTH), f32) * S5_WIDTH ** -0.5
    b_glu = 0.02 * jax.random.normal(ks[13], (N_EVEN, S5_WIDTH), f32)
    w_out_even = jax.random.normal(ks[14], (N_EVEN, EVEN_MIX, D_MODEL), f32) * EVEN_MIX ** -0.5
    norm_odd_g = 1.0 + 0.05 * jax.random.normal(ks[15], (N_ODD, D_MODEL), f32)
    w_in_odd = jax.random.normal(ks[16], (N_ODD, D_MODEL, W_IN_ODD), f32) * D_MODEL ** -0.5
    b_forget = jax.random.uniform(ks[17], (N_ODD, C_HEADS), f32, 1.0, 4.0)
    w_out_odd = jax.random.normal(ks[18], (N_ODD, C_WIDTH, D_MODEL), f32) * C_WIDTH ** -0.5
    final_norm_g = 1.0 + 0.05 * jax.random.normal(ks[19], (D_MODEL,), f32)
    return {"x": x, "norm_even_g": norm_even_g, "w_in_even": w_in_even, "rel_bias": rel_bias,
            "s5_lambda_re": s5_lambda_re, "s5_lambda_im": s5_lambda_im, "s5_log_dt": s5_log_dt,
            "s5_b_re": s5_b_re, "s5_b_im": s5_b_im, "s5_c_re": s5_c_re, "s5_c_im": s5_c_im,
            "s5_d": s5_d, "w_glu": w_glu, "b_glu": b_glu, "w_out_even": w_out_even,
            "norm_odd_g": norm_odd_g, "w_in_odd": w_in_odd, "b_forget": b_forget,
            "w_out_odd": w_out_odd, "final_norm_g": final_norm_g}


def reference(x, norm_even_g, w_in_even, rel_bias, s5_lambda_re, s5_lambda_im, s5_log_dt,
              s5_b_re, s5_b_im, s5_c_re, s5_c_im, s5_d, w_glu, b_glu, w_out_even,
              norm_odd_g, w_in_odd, b_forget, w_out_odd, final_norm_g):
    for layer in range(DEPTH):
        i = layer // 2
        if layer % 2 == 0:
            x = even_layer(x, norm_even_g[i], w_in_even[i], rel_bias[i], s5_lambda_re[i],
                           s5_lambda_im[i], s5_log_dt[i], s5_b_re[i], s5_b_im[i], s5_c_re[i],
                           s5_c_im[i], s5_d[i], w_glu[i], b_glu[i], w_out_even[i])
        else:
            x = odd_layer(x, norm_odd_g[i], w_in_odd[i], b_forget[i], w_out_odd[i])
    return rmsnorm(x, final_norm_g)
```

```cpp
#include <hip/hip_runtime.h>
#include <hip/hip_cooperative_groups.h>
#include <cstdio>
#include <cstdint>
namespace cg = cooperative_groups;
#define DI __device__ __forceinline__
#define LAS __attribute__((address_space(3)))
namespace pg8 {
#define PG8_LAS __attribute__((address_space(3)))
typedef unsigned short bf16_t;
typedef short bf16x8 __attribute__((ext_vector_type(8)));
typedef float f32x4 __attribute__((ext_vector_type(4)));
typedef unsigned u32x4 __attribute__((ext_vector_type(4)));
constexpr int BM = 256, BK = 64, HALF = 128, HTB = HALF * BK * 2  , STAGE_BYTES = 8 * HTB, NXCD = 8, WGM = 8;

__host__ __device__ __forceinline__ int lds_byte(int r, int c) { const int st = (r >> 4) * 2 + (c >> 5), rr = r & 15, cc = c & 31, ob = rr * 64 + cc * 2; return st * 1024 + (ob ^ (((ob >> 9) & 1) << 5)); }
__host__ __device__ __forceinline__ void stage_rc(int b, int& R, int& C) { const int st = b / 1024, sb = b % 1024, swz = sb ^ (((sb >> 9) & 1) << 5); R = (st >> 1) * 16 + swz / 64; C = (st & 1) * 32 + (swz % 64) / 2; }
__host__ __device__ __forceinline__ int perm32(int rho) { const int n = rho >> 4, i = rho & 15; return 8 * (i >> 2) + 4 * n + (i & 3); }

struct Unit { int pm, pn; };
struct Gemm { const bf16_t* A; const bf16_t* Bt; int M, N, K; };

struct StaticOrder {
    int nM, nN, nwg, G, c;
    __host__ __device__ void init(int M, int N, int G_, int c_) { nM = M / BM; nN = N / BM; nwg = nM * nN; G = G_; c = c_; }
    __host__ __device__ bool next(int i, Unit& u) const {
        const long L = (long)i * G + c; if (L >= nwg) return false;
        int wgid = (int)L; { const int q = nwg / NXCD, r = nwg % NXCD, xcd = wgid % NXCD, off = wgid / NXCD; wgid = (xcd < r ? xcd * (q + 1) : r * (q + 1) + (xcd - r) * q) + off; }
        const int nig = WGM * nN, gid = wgid / nig, fm = gid * WGM, gsz = (nM - fm) < WGM ? (nM - fm) : WGM;
        u.pm = fm + ((wgid % nig) % gsz); u.pn = (wgid % nig) / gsz; return true;
    }
    __device__ __forceinline__ void a_ready(const Unit&) const {}
    __device__ __forceinline__ void done(const Unit&) const {}
};


typedef unsigned u32x2 __attribute__((ext_vector_type(2)));
typedef float f32x2 __attribute__((ext_vector_type(2)));
typedef __bf16 bf16x2_t __attribute__((ext_vector_type(2)));
__device__ __forceinline__ unsigned cvtpk(float lo, float hi) { f32x2 v = {lo, hi}; bf16x2_t b = __builtin_convertvector(v, bf16x2_t); return __builtin_bit_cast(unsigned, b); }
__device__ __forceinline__ float bf_lo(unsigned u) { return __builtin_bit_cast(float, u << 16); }
__device__ __forceinline__ float bf_hi(unsigned u) { return __builtin_bit_cast(float, u & 0xffff0000u); }
__device__ __forceinline__ float sigm(float v) { return __builtin_amdgcn_rcpf(1.f + __expf(-v)); }

struct EpiProj {
    static constexpr bool PERM = true, AFTER_DRAIN = false;
    bf16_t* O; int ldc; const float* ssq; int qcols; float qscale;
    __device__ __forceinline__ void operator()(const f32x4 (&acc)[2][2][4][2], const Unit& u, int wr, int wc, int fr, int fq) const {
        const int row0 = u.pm * BM + wr * 64 + fr, col0 = u.pn * BM + wc * 32 + 8 * fq;
        const float cs = (u.pn * BM < qcols) ? qscale : 1.f;
#pragma unroll
        for (int ai = 0; ai < 2; ++ai)
#pragma unroll
            for (int m = 0; m < 4; ++m) {
                const int row = row0 + ai * HALF + m * 16;
                const float rs = cs / sqrtf(ssq[row] * (1.f / 2048.f) + 1e-6f);
                bf16_t* rowp = O + (size_t)row * ldc + col0;
#pragma unroll
                for (int bj = 0; bj < 2; ++bj) {
                    const f32x4 v0 = acc[ai][bj][m][0] * rs, v1 = acc[ai][bj][m][1] * rs;
                    u32x4 w; w.x = cvtpk(v0[0], v0[1]); w.y = cvtpk(v0[2], v0[3]); w.z = cvtpk(v1[0], v1[1]); w.w = cvtpk(v1[2], v1[3]);
                    *(u32x4*)(rowp + bj * HALF) = w;
                }
            }
    }
};

struct EpiGlu {
    static constexpr bool PERM = true, AFTER_DRAIN = false;
    const bf16_t* Y; int ldy; const bf16_t* ZB; int ldz; const float* bias; bf16_t* O; int ldo;
    __device__ __forceinline__ void operator()(const f32x4 (&acc)[2][2][4][2], const Unit& u, int wr, int wc, int fr, int fq) const {
        const int row0 = u.pm * BM + wr * 64 + fr, col0 = u.pn * BM + wc * 32 + 8 * fq;
#pragma unroll
        for (int ai = 0; ai < 2; ++ai)
#pragma unroll
            for (int m = 0; m < 4; ++m) {
                const int row = row0 + ai * HALF + m * 16;
#pragma unroll
                for (int bj = 0; bj < 2; ++bj) {
                    const int c = col0 + bj * HALF;
                    const u32x4 y8 = *(const u32x4*)(Y + (size_t)row * ldy + c), z8 = *(const u32x4*)(ZB + (size_t)row * ldz + c);
                    const f32x4 b0 = *(const f32x4*)(bias + c), b1 = *(const f32x4*)(bias + c + 4);
                    const f32x4 v0 = acc[ai][bj][m][0] + b0, v1 = acc[ai][bj][m][1] + b1;
                    float o[8];
#pragma unroll
                    for (int e = 0; e < 8; ++e) {
                        const unsigned yy = y8[e >> 1], zz = z8[e >> 1];
                        const float y = (e & 1) ? bf_hi(yy) : bf_lo(yy), z = (e & 1) ? bf_hi(zz) : bf_lo(zz);
                        const float v = e < 4 ? v0[e & 3] : v1[e & 3];
                        o[e] = y * sigm(v) * z * sigm(z);
                    }
                    u32x4 w; w.x = cvtpk(o[0], o[1]); w.y = cvtpk(o[2], o[3]); w.z = cvtpk(o[4], o[5]); w.w = cvtpk(o[6], o[7]);
                    *(u32x4*)(O + (size_t)row * ldo + c) = w;
                }
            }
    }
};

struct EpiRes {
    static constexpr bool PERM = true, AFTER_DRAIN = false;
    const float* R; const bf16_t* RB; float* OF; bf16_t* OB; float* ssq;
    __device__ __forceinline__ void operator()(const f32x4 (&acc)[2][2][4][2], const Unit& u, int wr, int wc, int fr, int fq) const {
        const int row0 = u.pm * BM + wr * 64 + fr, col0 = u.pn * BM + wc * 32 + 8 * fq;
#pragma unroll
        for (int ai = 0; ai < 2; ++ai) {
            f32x4 rr[4][2][2];
#pragma unroll
            for (int m = 0; m < 4; ++m)
#pragma unroll
                for (int bj = 0; bj < 2; ++bj) {
                    const size_t off = (size_t)(row0 + ai * HALF + m * 16) * 2048 + col0 + bj * HALF;
                    if (RB) { const u32x4 h = *(const u32x4*)(RB + off);
                        rr[m][bj][0] = (f32x4){bf_lo(h.x), bf_hi(h.x), bf_lo(h.y), bf_hi(h.y)}; rr[m][bj][1] = (f32x4){bf_lo(h.z), bf_hi(h.z), bf_lo(h.w), bf_hi(h.w)}; }
                    else { rr[m][bj][0] = *(const f32x4*)(R + off); rr[m][bj][1] = *(const f32x4*)(R + off + 4); }
                }
            __builtin_amdgcn_sched_barrier(0);
#pragma unroll
            for (int m = 0; m < 4; ++m) {
                const int row = row0 + ai * HALF + m * 16;
                float s = 0.f;
#pragma unroll
                for (int bj = 0; bj < 2; ++bj) {
                    const size_t off = (size_t)row * 2048 + col0 + bj * HALF;
                    const f32x4 v0 = acc[ai][bj][m][0] + rr[m][bj][0], v1 = acc[ai][bj][m][1] + rr[m][bj][1];
                    if (OF) { *(f32x4*)(OF + off) = v0; *(f32x4*)(OF + off + 4) = v1; }
                    if (OB) { u32x4 w; w.x = cvtpk(v0[0], v0[1]); w.y = cvtpk(v0[2], v0[3]); w.z = cvtpk(v1[0], v1[1]); w.w = cvtpk(v1[2], v1[3]); *(u32x4*)(OB + off) = w; }
                    s += (v0[0] * v0[0] + v0[1] * v0[1]) + (v0[2] * v0[2] + v0[3] * v0[3]) + (v1[0] * v1[0] + v1[1] * v1[1]) + (v1[2] * v1[2] + v1[3] * v1[3]);
                }
                s += __shfl_xor(s, 16); s += __shfl_xor(s, 32);
                if (fq == 0) atomicAdd(ssq + row, s);
            }
            __builtin_amdgcn_sched_barrier(0);
        }
    }
};

struct EpiResNorm {
    static constexpr bool PERM = true, AFTER_DRAIN = false;
    const bf16_t* RB; float* OF; float* ssq; unsigned* cnt; const float* gfin;
    __device__ __forceinline__ void operator()(f32x4 (&acc)[2][2][4][2], const Unit& u, int wr, int wc, int fr, int fq) const {
        const int row0 = u.pm * BM + wr * 64 + fr, col0 = u.pn * BM + wc * 32 + 8 * fq;
#pragma unroll
        for (int ai = 0; ai < 2; ++ai) {
            f32x4 rr[4][2][2];
#pragma unroll
            for (int m = 0; m < 4; ++m)
#pragma unroll
                for (int bj = 0; bj < 2; ++bj) {
                    const size_t off = (size_t)(row0 + ai * HALF + m * 16) * 2048 + col0 + bj * HALF;
                    const u32x4 h = *(const u32x4*)(RB + off);
                    rr[m][bj][0] = (f32x4){bf_lo(h.x), bf_hi(h.x), bf_lo(h.y), bf_hi(h.y)}; rr[m][bj][1] = (f32x4){bf_lo(h.z), bf_hi(h.z), bf_lo(h.w), bf_hi(h.w)};
                }
            __builtin_amdgcn_sched_barrier(0);
#pragma unroll
            for (int m = 0; m < 4; ++m) {
                const int row = row0 + ai * HALF + m * 16;
                float s = 0.f;
#pragma unroll
                for (int bj = 0; bj < 2; ++bj) {
                    const f32x4 v0 = acc[ai][bj][m][0] + rr[m][bj][0], v1 = acc[ai][bj][m][1] + rr[m][bj][1];
                    acc[ai][bj][m][0] = v0; acc[ai][bj][m][1] = v1;
                    s += (v0[0] * v0[0] + v0[1] * v0[1]) + (v0[2] * v0[2] + v0[3] * v0[3]) + (v1[0] * v1[0] + v1[1] * v1[1]) + (v1[2] * v1[2] + v1[3] * v1[3]);
                }
                s += __shfl_xor(s, 16); s += __shfl_xor(s, 32);
                if (fq == 0) atomicAdd(ssq + row, s);
            }
            __builtin_amdgcn_sched_barrier(0);
        }
        asm volatile("s_waitcnt vmcnt(0)" ::: "memory");
        __syncthreads();
        if (threadIdx.x == 0) {
            unsigned* c = cnt + 64 * u.pm;
            (void)__hip_atomic_fetch_add(c, 1u, __ATOMIC_RELAXED, __HIP_MEMORY_SCOPE_AGENT);
            unsigned sp = 0;
            while (__hip_atomic_load(c, __ATOMIC_RELAXED, __HIP_MEMORY_SCOPE_AGENT) < 8u) { __builtin_amdgcn_s_sleep(1); if (++sp > (1u << 22)) break; }
        }
        __syncthreads();
#pragma unroll
        for (int ai = 0; ai < 2; ++ai)
#pragma unroll
            for (int m = 0; m < 4; ++m) {
                const int row = row0 + ai * HALF + m * 16;
                const float rs = 1.f / sqrtf(__hip_atomic_load(ssq + row, __ATOMIC_RELAXED, __HIP_MEMORY_SCOPE_AGENT) * (1.f / 2048.f) + 1e-6f);
#pragma unroll
                for (int bj = 0; bj < 2; ++bj) {
                    const size_t off = (size_t)row * 2048 + col0 + bj * HALF;
                    const f32x4 g0 = *(const f32x4*)(gfin + col0 + bj * HALF), g1 = *(const f32x4*)(gfin + col0 + bj * HALF + 4);
                    *(f32x4*)(OF + off) = acc[ai][bj][m][0] * rs * g0; *(f32x4*)(OF + off + 4) = acc[ai][bj][m][1] * rs * g1;
                }
            }
    }
};

struct PanelOrder {
    int nwg, G, c, nN;
    __host__ __device__ void init(int M, int N, int G_, int c_) { nN = N / BM; nwg = (M / BM) * nN; G = G_; c = c_; }
    __host__ __device__ bool next(int i, Unit& u) const { const long L = (long)i * G + c; if (L >= nwg) return false; u.pm = (int)(L / nN); u.pn = (int)(L % nN); return true; }
    __device__ __forceinline__ void a_ready(const Unit&) const {}
    __device__ __forceinline__ void done(const Unit&) const {}
};
template <class Epi, class Sched, bool ALIGN_EPI = false, bool SP2 = false>
__device__ __forceinline__ void gemm_phase(PG8_LAS unsigned char* lds, const Gemm g, const Sched& S, const Epi& E) {
    const int tid = threadIdx.x, wid = __builtin_amdgcn_readfirstlane(tid >> 6), lane = tid & 63, wr = wid >> 2, wc = wid & 3, fr = lane & 15, fq = lane >> 4;
    const int K = g.K, nt = K / BK;
    unsigned voffA[2], voffB[2];
#pragma unroll
    for (int i = 0; i < 2; ++i) { int R, C; stage_rc(tid * 16 + i * 8192, R, C); const int Rb = Epi::PERM ? ((R & ~31) + perm32(R & 31)) : R;
        voffA[i] = (unsigned)(R * K + C) * 2u; voffB[i] = (unsigned)(Rb * K + C) * 2u; }
    const size_t kstep = (size_t)(BK * 2);
    const size_t hstep = (size_t)HALF * K * 2;
    const size_t tstep = 2 * hstep;
    const unsigned ldsw = (unsigned)wid * 1024u;
    const int aoff = lds_byte(wr * 64 + fr, fq * 8), boff = lds_byte(wc * 32 + fr, fq * 8);
#define PG8_SA(b, h) (((b) * 2 + (h)) * HTB)
#define PG8_SB(b, h) ((4 + (b) * 2 + (h)) * HTB)
#define PG8_STAGE(bufoff, gbase, voff) do { _Pragma("unroll") for (int _i = 0; _i < 2; ++_i) \
        __builtin_amdgcn_global_load_lds((const unsigned*)((const char*)(gbase) + (voff)[_i]), (PG8_LAS unsigned*)(lds + (bufoff) + ldsw + _i * 8192), 16, 0, 0); } while (0)
#define PG8_LDA(dst, b, h) do { _Pragma("unroll") for (int m = 0; m < 4; ++m) _Pragma("unroll") for (int k = 0; k < 2; ++k) dst[m][k] = *(const PG8_LAS bf16x8*)(lds + PG8_SA(b, h) + aoff + m * 2048 + k * 1024); } while (0)
#define PG8_LDB(dst, b, h) do { _Pragma("unroll") for (int n = 0; n < 2; ++n) _Pragma("unroll") for (int k = 0; k < 2; ++k) dst[n][k] = *(const PG8_LAS bf16x8*)(lds + PG8_SB(b, h) + boff + n * 2048 + k * 1024); } while (0)
#define PG8_MMA(ai, bj, At, Bt) do { __builtin_amdgcn_s_setprio(1); _Pragma("unroll") for (int m = 0; m < 4; ++m) _Pragma("unroll") for (int n = 0; n < 2; ++n) _Pragma("unroll") for (int k = 0; k < 2; ++k) \
        acc[ai][bj][m][n] = __builtin_amdgcn_mfma_f32_16x16x32_bf16(Bt[n][k], At[m][k], acc[ai][bj][m][n], 0, 0, 0); __builtin_amdgcn_s_setprio(0); } while (0)
#define PG8_WAIT_V(n) asm volatile("s_waitcnt vmcnt(" #n ")" ::: "memory")
#define PG8_WAIT_L(n) asm volatile("s_waitcnt lgkmcnt(" #n ")" ::: "memory")
#define PG8_BAR __builtin_amdgcn_s_barrier()
#define PG8_SCHED __builtin_amdgcn_sched_barrier(0)
    Unit cur, nxt; int ui = 0;
    if (!S.next(0, cur)) return;
    f32x4 acc[2][2][4][2];
#pragma unroll
    for (int a = 0; a < 2; ++a)
#pragma unroll
        for (int b = 0; b < 2; ++b)
#pragma unroll
            for (int m = 0; m < 4; ++m)
#pragma unroll
                for (int n = 0; n < 2; ++n) acc[a][b][m][n] = (f32x4){0.f, 0.f, 0.f, 0.f};
    bf16x8 At[4][2], B0[2][2], B1[2][2];
    const char* cA = (const char*)g.A + (size_t)cur.pm * tstep; const char* cB = (const char*)g.Bt + (size_t)cur.pn * tstep;
    S.a_ready(cur);
    if constexpr (SP2) {
        PG8_STAGE(PG8_SB(0, 0), cB, voffB); PG8_STAGE(PG8_SB(0, 1), cB + hstep, voffB); PG8_STAGE(PG8_SA(0, 0), cA, voffA); PG8_STAGE(PG8_SA(0, 1), cA + hstep, voffA);
        if (wr == 1) PG8_BAR;
        PG8_WAIT_V(2); PG8_BAR;
        PG8_STAGE(PG8_SB(1, 0), cB + kstep, voffB); PG8_STAGE(PG8_SA(1, 0), cA + kstep, voffA); PG8_STAGE(PG8_SB(1, 1), cB + hstep + kstep, voffB);
        PG8_WAIT_V(6); PG8_BAR;
    } else {
        PG8_STAGE(PG8_SB(0, 0), cB, voffB); PG8_STAGE(PG8_SA(0, 0), cA, voffA); PG8_STAGE(PG8_SB(0, 1), cB + hstep, voffB); PG8_STAGE(PG8_SA(0, 1), cA + hstep, voffA);
        if (wr == 1) PG8_BAR;
        PG8_WAIT_V(4); PG8_BAR;
        PG8_STAGE(PG8_SB(1, 0), cB + kstep, voffB); PG8_STAGE(PG8_SA(1, 0), cA + kstep, voffA); PG8_STAGE(PG8_SB(1, 1), cB + hstep + kstep, voffB);
        PG8_WAIT_V(6); PG8_BAR;
    }
    for (;;) {
        const bool has_next = S.next(ui + 1, nxt);
        const char* nA = has_next ? (const char*)g.A + (size_t)nxt.pm * tstep : cA; const char* nB = has_next ? (const char*)g.Bt + (size_t)nxt.pn * tstep : cB;
        for (int t = 0; t < nt; t += 2) {
            const bool last = (t == nt - 2);
            const char* a1 = cA + (size_t)(t + 1) * kstep;
            const char* a2 = last ? nA : cA + (size_t)(t + 2) * kstep; const char* b2 = last ? nB : cB + (size_t)(t + 2) * kstep;
            const char* a3 = a2 + kstep; const char* b3 = b2 + kstep;
            if (last && has_next) S.a_ready(nxt);
            if constexpr (SP2) {
            PG8_LDB(B0, 0, 0); PG8_LDB(B1, 0, 1); PG8_SCHED; PG8_LDA(At, 0, 0); PG8_STAGE(PG8_SA(1, 1), a1 + hstep, voffA);
            PG8_WAIT_V(8); PG8_WAIT_L(0); PG8_BAR; PG8_MMA(0, 0, At, B0); PG8_MMA(0, 1, At, B1); PG8_BAR; PG8_SCHED;
            PG8_LDA(At, 0, 1); PG8_STAGE(PG8_SB(0, 0), b2, voffB); PG8_STAGE(PG8_SB(0, 1), b2 + hstep, voffB); PG8_STAGE(PG8_SA(0, 0), a2, voffA);
            PG8_WAIT_V(8); PG8_WAIT_L(0); PG8_BAR; PG8_MMA(1, 0, At, B0); PG8_MMA(1, 1, At, B1); PG8_BAR; PG8_SCHED;
            PG8_LDB(B0, 1, 0); PG8_LDB(B1, 1, 1); PG8_SCHED; PG8_LDA(At, 1, 0); PG8_STAGE(PG8_SA(0, 1), a2 + hstep, voffA);
            PG8_WAIT_V(8); PG8_WAIT_L(0); PG8_BAR; PG8_MMA(0, 0, At, B0); PG8_MMA(0, 1, At, B1); PG8_BAR; PG8_SCHED;
            PG8_LDA(At, 1, 1); PG8_STAGE(PG8_SB(1, 0), b3, voffB); PG8_STAGE(PG8_SB(1, 1), b3 + hstep, voffB); PG8_STAGE(PG8_SA(1, 0), a3, voffA);
            PG8_WAIT_V(8); PG8_WAIT_L(0); PG8_BAR; PG8_MMA(1, 0, At, B0); PG8_MMA(1, 1, At, B1); PG8_BAR; PG8_SCHED;
            } else {
            PG8_LDB(B0, 0, 0); PG8_SCHED; PG8_LDA(At, 0, 0); PG8_STAGE(PG8_SA(1, 1), a1 + hstep, voffA);
            PG8_WAIT_L(8); PG8_BAR; PG8_WAIT_L(0); PG8_MMA(0, 0, At, B0); PG8_BAR; PG8_SCHED;
            PG8_LDB(B1, 0, 1); PG8_STAGE(PG8_SB(0, 0), b2, voffB);
            PG8_BAR; PG8_WAIT_L(0); PG8_MMA(0, 1, At, B1); PG8_BAR;
            PG8_LDA(At, 0, 1); PG8_STAGE(PG8_SA(0, 0), a2, voffA);
            PG8_BAR; PG8_WAIT_L(0); PG8_MMA(1, 0, At, B0); PG8_BAR; PG8_SCHED;
            PG8_STAGE(PG8_SB(0, 1), b2 + hstep, voffB);
            PG8_WAIT_V(6); PG8_BAR; PG8_MMA(1, 1, At, B1); PG8_BAR;
            PG8_LDB(B0, 1, 0); PG8_SCHED; PG8_LDA(At, 1, 0); PG8_STAGE(PG8_SA(0, 1), a2 + hstep, voffA);
            PG8_WAIT_L(8); PG8_BAR; PG8_WAIT_L(0); PG8_MMA(0, 0, At, B0); PG8_BAR; PG8_SCHED;
            PG8_LDB(B1, 1, 1); PG8_STAGE(PG8_SB(1, 0), b3, voffB);
            PG8_BAR; PG8_WAIT_L(0); PG8_MMA(0, 1, At, B1); PG8_BAR;
            PG8_LDA(At, 1, 1); PG8_STAGE(PG8_SA(1, 0), a3, voffA);
            PG8_BAR; PG8_WAIT_L(0); PG8_MMA(1, 0, At, B0); PG8_BAR; PG8_SCHED;
            PG8_STAGE(PG8_SB(1, 1), b3 + hstep, voffB);
            PG8_WAIT_V(6); PG8_BAR; PG8_MMA(1, 1, At, B1); PG8_BAR;
            }
        }
        if constexpr (ALIGN_EPI) { if (wr == 0) PG8_BAR; }
        if constexpr (!Epi::AFTER_DRAIN) { E(acc, cur, wr, wc, fr, fq); S.done(cur); }
        if (!has_next) break;
#pragma unroll
        for (int a = 0; a < 2; ++a)
#pragma unroll
            for (int b = 0; b < 2; ++b)
#pragma unroll
                for (int m = 0; m < 4; ++m)
#pragma unroll
                    for (int n = 0; n < 2; ++n) acc[a][b][m][n] = (f32x4){0.f, 0.f, 0.f, 0.f};
        cur = nxt; cA = nA; cB = nB; ++ui;
        if constexpr (ALIGN_EPI) { if (wr == 1) PG8_BAR; }
    }
    PG8_WAIT_V(0);
    if constexpr (!ALIGN_EPI) { if (wr == 0) PG8_BAR; }
    PG8_BAR;
    if constexpr (Epi::AFTER_DRAIN) { E.fused(acc, cur, wr, wc, fr, fq, lds, wid, lane); S.done(cur); }
#undef PG8_SA
#undef PG8_SB
#undef PG8_STAGE
#undef PG8_LDA
#undef PG8_LDB
#undef PG8_MMA
#undef PG8_WAIT_V
#undef PG8_WAIT_L
#undef PG8_BAR
#undef PG8_SCHED
}
}

using pg8::bf16_t; using pg8::bf16x8; using pg8::f32x4; using pg8::u32x4; using pg8::u32x2; using pg8::f32x2; using pg8::cvtpk; using pg8::bf_lo; using pg8::bf_hi; using pg8::sigm;
typedef short s16x4 __attribute__((ext_vector_type(4)));
typedef float f32x16 __attribute__((ext_vector_type(16)));
typedef short v4i16_t __attribute__((ext_vector_type(4)));
constexpr int M = 16384, DM = 2048, SEQ = 4096;
constexpr float LOG2E = 1.4426950408889634f;
constexpr size_t MiB = 1u << 20;
constexpr size_t WS_SSQ0 = 0, WS_SSQ1 = 65536, WS_SSQ2 = 131072, WS_BTOT = 196608, WS_BAR = 524288, WS_CNT = 327680, WS_S5TAB = 1048576;
constexpr int LDS_MISC = 143360;
constexpr size_t WS_W0T = 2 * MiB, WS_WGT = 26 * MiB, WS_WO0T = 28 * MiB, WS_W1T = 36 * MiB, WS_WFT = 68 * MiB, WS_WO1T = 69 * MiB;
constexpr size_t WS_S5ST = 77 * MiB, WS_CUML = 85 * MiB, WS_XB = 86 * MiB;
constexpr size_t WS_P0 = 150 * MiB, WS_YG = 342 * MiB, WS_MIX = 374 * MiB, WS_P1 = 150 * MiB, WS_OG = 438 * MiB, WS_END = 502 * MiB;
constexpr int LDS_BYTES = 147456;
#ifndef DUP
#define DUP -1
#endif
#define REP(k) for (int rep_ = 0; rep_ < ((DUP == (k)) ? 2 : 1); ++rep_)

struct Args { const float* in[20]; float* out; unsigned char* ws; int ph_lo, ph_hi; };

DI s16x4 vtr(LAS const unsigned char* p) { return __builtin_bit_cast(s16x4, __builtin_amdgcn_ds_read_tr16_b64_v4i16((LAS v4i16_t*)p)); }
DI float wave_sum(float v) {
#pragma unroll
    for (int o = 1; o < 64; o <<= 1) v += __shfl_xor(v, o);
    return v;
}

DI float xhalf_max(float v) { float a = v, b = v; asm volatile("v_nop\n\tv_nop\n\tv_permlane32_swap_b32 %0, %1" : "+v"(a), "+v"(b)); return fmaxf(a, b); }
DI float xhalf_sum(float v) { float a = v, b = v; asm volatile("v_nop\n\tv_nop\n\tv_permlane32_swap_b32 %0, %1" : "+v"(a), "+v"(b)); return a + b; }

template <int D, int MODE>
DI void attn_unit(LAS unsigned char* lds, const bf16_t* QKV, const int LD, const int qoff, const int koff, const int voff,
                  const bf16_t* Z, const int LDZ, const int zoff, bf16_t* OUT, const int LDO, const int ooff,
                  const int b, const int h, const int qb, const float* aux0, const float* aux1, const bool keep_aux) {
    constexpr int ROWBK = D * 2 + 16, ROWBV = (D == 128) ? 320 : 192, KT = 64 * ROWBK, VT = 64 * ROWBV, VOFF = 2 * KT, AUX = 2 * KT + 2 * VT;
    constexpr int NCH = D / 64, CPR = D / 8, NKS = D / 16, NDT = D / 32;
    constexpr float THR = 64.f, NEG = -1e30f;
    int tid_ = threadIdx.x; asm volatile("" : "+v"(tid_));
    const int tid = tid_, lane = tid & 63, w = __builtin_amdgcn_readfirstlane(tid >> 6), r = lane & 31, hh = lane >> 5;
    const size_t rowbase = (size_t)b * SEQ; const int q0 = qb * 256;
    LAS float* auxf = (LAS float*)(lds + AUX);
    int kt0, kt1, ci = 0;
    if (MODE == 0) { const int c0 = qb * 4; kt0 = c0 - 8 < 0 ? 0 : c0 - 8; kt1 = c0 + 4; ci = c0 + (w >> 1); }
    else { kt0 = 0; kt1 = q0 / 64 + 4; }
    u32x4 kreg[NCH], vreg[NCH];
    const bf16_t* kvbase = QKV + rowbase * LD + h * D;
#define ATT_GLOAD(kt) do { _Pragma("unroll") for (int i_ = 0; i_ < NCH; ++i_) { const int c_ = tid + 512 * i_, row_ = c_ / CPR, c8_ = c_ % CPR; \
        const bf16_t* g_ = kvbase + (size_t)((kt) * 64 + row_) * LD + c8_ * 8; kreg[i_] = *(const u32x4*)(g_ + koff); vreg[i_] = *(const u32x4*)(g_ + voff); } } while (0)
#define ATT_LSTORE(buf) do { _Pragma("unroll") for (int i_ = 0; i_ < NCH; ++i_) { const int c_ = tid + 512 * i_, row_ = c_ / CPR, c8_ = c_ % CPR; \
        *(LAS u32x4*)(lds + (buf) * KT + row_ * ROWBK + c8_ * 16) = kreg[i_]; *(LAS u32x4*)(lds + VOFF + (buf) * VT + row_ * ROWBV + c8_ * 16) = vreg[i_]; } } while (0)
    bf16x8 qf[NKS];
    {
        const bf16_t* qp = QKV + (rowbase + q0 + w * 32 + r) * LD + qoff + h * D + 8 * hh;
#pragma unroll
        for (int ks = 0; ks < NKS; ++ks) qf[ks] = *(const bf16x8*)(qp + ks * 16);
    }
    ATT_GLOAD(kt0);
    if (!keep_aux) {
        if (MODE == 0) {
            for (int i = tid; i < 257; i += 512) auxf[i] = aux0[h * 257 + i] * LOG2E;
        } else {
            LAS float* pref = auxf + 4096;
            if (w == 0) {
                const float own = aux1[(b * 64 + lane) * 16 + h]; float v = own;
#pragma unroll
                for (int o = 1; o < 64; o <<= 1) { const float t = __shfl_up(v, o); if (lane >= o) v += t; }
                pref[lane] = v - own;
            }
            __syncthreads();
            const float* cl = aux0 + (size_t)(b * 16 + h) * SEQ;
            const int nk = q0 + 256;
#pragma unroll 1
            for (int kb = 0; kb < nk; kb += 2048) {
                float c[4];
#pragma unroll
                for (int j = 0; j < 4; ++j) { const int k = kb + tid + 512 * j; c[j] = (k < nk) ? cl[k] : 0.f; }
#pragma unroll
                for (int j = 0; j < 4; ++j) { const int k = kb + tid + 512 * j; if (k < nk) auxf[k] = (c[j] + pref[k >> 6]) * -LOG2E; }
            }
        }
    }
    __builtin_amdgcn_s_waitcnt(0x0F70);
    asm volatile("" ::: "memory");
    ATT_LSTORE(0);
    { const int t1_ = kt0 + 1 < kt1 ? kt0 + 1 : kt0; ATT_GLOAD(t1_); }
    f32x16 O[NDT];
#pragma unroll
    for (int dt = 0; dt < NDT; ++dt)
#pragma unroll
        for (int i = 0; i < 16; ++i) O[dt][i] = 0.f;
    float mref = NEG, lrun = 0.f;
    __syncthreads();
    const int q4 = (lane & 15) >> 2, p4 = lane & 3, blk = (lane >> 4) & 1;
    const int qw = q0 + 32 * w;
    for (int kt = kt0; kt < kt1; ++kt) {
        const int buf = (kt - kt0) & 1;
        if (kt != kt0) { ATT_LSTORE(buf ^ 1); const int t2_ = kt + 2 < kt1 ? kt + 2 : kt1 - 1; ATT_GLOAD(t2_); }
        bool active; int jrel = 0;
        if (MODE == 0) { jrel = ci - kt; active = (jrel >= 0 && jrel <= 8); } else { active = (kt * 64 <= qw); }
        if (active) {
            const int k0 = kt * 64;
            LAS const unsigned char* kp = lds + buf * KT + r * ROWBK + hh * 16;
            bf16x8 kf[2][4];
#define ATT_KLOAD(g_, slot_) do { _Pragma("unroll") for (int q_ = 0; q_ < 2; ++q_) { kf[slot_][2 * q_] = *(LAS const bf16x8*)(kp + (2 * (g_) + q_) * 32); kf[slot_][2 * q_ + 1] = *(LAS const bf16x8*)(kp + 32 * ROWBK + (2 * (g_) + q_) * 32); } } while (0)
            ATT_KLOAD(0, 0);
            f32x16 S0, S1;
            if (MODE == 1) {
                LAS const float* ckp = auxf + k0 + 4 * hh;
#pragma unroll
                for (int g = 0; g < 4; ++g) {
                    const f32x4 c0 = *(LAS const f32x4*)(ckp + 8 * g), c1 = *(LAS const f32x4*)(ckp + 32 + 8 * g);
#pragma unroll
                    for (int e = 0; e < 4; ++e) { S0[4 * g + e] = c0[e]; S1[4 * g + e] = c1[e]; }
                }
            } else {
                if (jrel >= 3) { const float bfar = auxf[256];
#pragma unroll
                    for (int i = 0; i < 16; ++i) { S0[i] = bfar; S1[i] = bfar; }
                } else {
                    const int base = jrel * 64 + (w & 1) * 32 + r + 128 - 4 * hh;
#pragma unroll
                    for (int i = 0; i < 16; ++i) { const int cr = (i & 3) + 8 * (i >> 2); int i0 = base - cr, i1 = base - 32 - cr; i0 = i0 > 256 ? 256 : i0; i1 = i1 > 256 ? 256 : i1; S0[i] = auxf[i0]; S1[i] = auxf[i1]; }
                }
            }
            __builtin_amdgcn_sched_barrier(0);
#pragma unroll
            for (int g = 0; g < NKS / 2; ++g) {
                if (g + 1 < NKS / 2) ATT_KLOAD(g + 1, (g + 1) & 1);
#pragma unroll
                for (int q = 0; q < 2; ++q) {
                    S0 = __builtin_amdgcn_mfma_f32_32x32x16_bf16(kf[g & 1][2 * q], qf[2 * g + q], S0, 0, 0, 0);
                    S1 = __builtin_amdgcn_mfma_f32_32x32x16_bf16(kf[g & 1][2 * q + 1], qf[2 * g + q], S1, 0, 0, 0);
                    if (DUP == 201 && MODE == 1) {
                        const bf16x8 n0 = kf[g & 1][2 * q] ^ (short)0x8000, n1 = kf[g & 1][2 * q + 1] ^ (short)0x8000;
                        S0 = __builtin_amdgcn_mfma_f32_32x32x16_bf16(n0, qf[2 * g + q], S0, 0, 0, 0); S1 = __builtin_amdgcn_mfma_f32_32x32x16_bf16(n1, qf[2 * g + q], S1, 0, 0, 0);
                        S0 = __builtin_amdgcn_mfma_f32_32x32x16_bf16(kf[g & 1][2 * q], qf[2 * g + q], S0, 0, 0, 0); S1 = __builtin_amdgcn_mfma_f32_32x32x16_bf16(kf[g & 1][2 * q + 1], qf[2 * g + q], S1, 0, 0, 0);
                    }
                }
                __builtin_amdgcn_sched_barrier(0);
            }
#undef ATT_KLOAD
            if (MODE == 1) {
                if (k0 + 63 > qw) {
                    const int lim = qw + r - k0;
#pragma unroll
                    for (int i = 0; i < 16; ++i) { const int kl = (i & 3) + 8 * (i >> 2) + 4 * hh; if (kl > lim) S0[i] = NEG; if (kl + 32 > lim) S1[i] = NEG; }
                }
            }
            float mx;
            asm volatile("s_nop 15\n\ts_nop 3\n\tv_max3_f32 %0, %1, %2, %3" : "=v"(mx) : "v"(S0[0]), "v"(S1[0]), "v"(S0[1]));
#pragma unroll
            for (int i = 1; i < 15; ++i) asm volatile("v_max3_f32 %0, %0, %1, %2" : "+v"(mx) : "v"(S1[i]), "v"(S0[i + 1]));
            asm volatile("v_max_f32 %0, %0, %1" : "+v"(mx) : "v"(S1[15]));
            mx = xhalf_max(mx);
            if (__any(mx > mref + THR)) {
                const float mnew = fmaxf(mref, mx);
                const float alpha = __builtin_amdgcn_exp2f(mref - mnew);
                mref = mnew; lrun *= alpha;
#pragma unroll
                for (int dt = 0; dt < NDT; ++dt)
#pragma unroll
                    for (int i = 0; i < 16; ++i) O[dt][i] *= alpha;
            }
            float ps = 0.f;
#pragma unroll
            for (int i = 0; i < 16; ++i) { S0[i] = __builtin_amdgcn_exp2f(S0[i] - mref); S1[i] = __builtin_amdgcn_exp2f(S1[i] - mref); ps += S0[i] + S1[i]; }
            lrun += ps;
            bf16x8 pf[4];
#pragma unroll
            for (int s = 0; s < 2; ++s) {
                u32x4 pk; pk.x = cvtpk(S0[8 * s], S0[8 * s + 1]); pk.y = cvtpk(S0[8 * s + 2], S0[8 * s + 3]); pk.z = cvtpk(S0[8 * s + 4], S0[8 * s + 5]); pk.w = cvtpk(S0[8 * s + 6], S0[8 * s + 7]); pf[s] = __builtin_bit_cast(bf16x8, pk);
                u32x4 pq; pq.x = cvtpk(S1[8 * s], S1[8 * s + 1]); pq.y = cvtpk(S1[8 * s + 2], S1[8 * s + 3]); pq.z = cvtpk(S1[8 * s + 4], S1[8 * s + 5]); pq.w = cvtpk(S1[8 * s + 6], S1[8 * s + 7]); pf[2 + s] = __builtin_bit_cast(bf16x8, pq);
            }
            __builtin_amdgcn_sched_barrier(0);
            LAS const unsigned char* vp = lds + VOFF + buf * VT + (4 * hh + q4) * ROWBV + blk * 32 + p4 * 8;
            s16x4 vlo[2][4], vhi[2][4];
#define ATT_VLOAD(dt_, slot_) do { _Pragma("unroll") for (int kk_ = 0; kk_ < 4; ++kk_) { vlo[slot_][kk_] = vtr(vp + (16 * kk_) * ROWBV + (dt_) * 64); vhi[slot_][kk_] = vtr(vp + (16 * kk_ + 8) * ROWBV + (dt_) * 64); } } while (0)
            ATT_VLOAD(0, 0);
            __builtin_amdgcn_sched_barrier(0);
#pragma unroll
            for (int dt = 0; dt < NDT; ++dt) {
                if (dt + 1 < NDT) ATT_VLOAD(dt + 1, (dt + 1) & 1);
#pragma unroll
                for (int kk = 0; kk < 4; ++kk) {
                    const bf16x8 vf = __builtin_shufflevector(vlo[dt & 1][kk], vhi[dt & 1][kk], 0, 1, 2, 3, 4, 5, 6, 7);
                    O[dt] = __builtin_amdgcn_mfma_f32_32x32x16_bf16(vf, pf[kk], O[dt], 0, 0, 0);
                }
                __builtin_amdgcn_sched_barrier(0);
            }
#undef ATT_VLOAD
        }
        if (kt == kt0) { ATT_LSTORE(buf ^ 1); const int t2_ = kt + 2 < kt1 ? kt + 2 : kt1 - 1; ATT_GLOAD(t2_); }
        asm volatile("s_waitcnt lgkmcnt(0)\n\ts_barrier" ::: "memory");
    }
#undef ATT_GLOAD
#undef ATT_LSTORE
    const float inv = 1.f / xhalf_sum(lrun);
    int lane2 = lane; asm volatile("" : "+v"(lane2));
    LAS unsigned char* st = lds + w * 32 * ROWBK;
    constexpr int NIT = 32 * CPR / 64;
    u32x4 zq[NIT];
#pragma unroll
    for (int it = 0; it < NIT; ++it) { const int idx = it * 64 + lane2, row = idx / CPR, c8 = idx % CPR; zq[it] = *(const u32x4*)(Z + (rowbase + q0 + w * 32 + row) * LDZ + zoff + h * D + c8 * 8); }
#pragma unroll
    for (int dt = 0; dt < NDT; ++dt)
#pragma unroll
        for (int g = 0; g < 4; ++g) {
            u32x2 pk; pk.x = cvtpk(O[dt][4 * g] * inv, O[dt][4 * g + 1] * inv); pk.y = cvtpk(O[dt][4 * g + 2] * inv, O[dt][4 * g + 3] * inv);
            *(LAS u32x2*)(st + (lane2 & 31) * ROWBK + (dt * 32 + 8 * g + 4 * (lane2 >> 5)) * 2) = pk;
        }
    asm volatile("s_waitcnt lgkmcnt(0)" ::: "memory");
#pragma unroll
    for (int it = 0; it < NIT; ++it) {
        const int idx = it * 64 + lane2, row = idx / CPR, c8 = idx % CPR;
        const u32x4 o8 = *(LAS const u32x4*)(st + row * ROWBK + c8 * 16);
        const size_t grow = rowbase + q0 + w * 32 + row;
        const u32x4 z8 = zq[it];
        u32x4 res;
#pragma unroll
        for (int e = 0; e < 4; ++e) {
            const float o0 = bf_lo(o8[e]), o1 = bf_hi(o8[e]), z0 = bf_lo(z8[e]), z1 = bf_hi(z8[e]);
            res[e] = cvtpk(o0 * z0 * sigm(z0), o1 * z1 * sigm(z1));
        }
        *(u32x4*)(OUT + grow * LDO + ooff + h * D + c8 * 8) = res;
    }
    __syncthreads();
}

DI double exp_d(double z) {
    const double n = rint(z * 1.4426950408889634074);
    const double rr = (z - n * 6.93147180369123816490e-01) - n * 1.90821492927058770002e-10;
    double p = 1.0 / 39916800.0;
    p = p * rr + 1.0 / 3628800.0; p = p * rr + 1.0 / 362880.0; p = p * rr + 1.0 / 40320.0; p = p * rr + 1.0 / 5040.0; p = p * rr + 1.0 / 720.0;
    p = p * rr + 1.0 / 120.0; p = p * rr + 1.0 / 24.0; p = p * rr + 1.0 / 6.0; p = p * rr + 0.5; p = p * rr + 1.0; p = p * rr + 1.0;
    const long long bits = (long long)(1023 + (int)n) << 52;
    return p * __builtin_bit_cast(double, bits);
}
DI void sincos_d(double x, double& sn, double& cs) {
    const double k = rint(x * 0.63661977236758134308);
    const double rr = (x - k * 1.57079632673412561417e+00) - k * 6.07710050650619224932e-11;
    const double r2 = rr * rr;
    double s = 1.0 / 6227020800.0; s = s * r2 - 1.0 / 39916800.0; s = s * r2 + 1.0 / 362880.0; s = s * r2 - 1.0 / 5040.0; s = s * r2 + 1.0 / 120.0; s = s * r2 - 1.0 / 6.0; s = rr + rr * r2 * s;
    double c = -1.0 / 87178291200.0; c = c * r2 + 1.0 / 479001600.0; c = c * r2 - 1.0 / 3628800.0; c = c * r2 + 1.0 / 40320.0; c = c * r2 - 1.0 / 720.0; c = c * r2 + 1.0 / 24.0; c = c * r2 - 0.5; c = 1.0 + c * r2;
    const int q = ((int)k) & 3;
    sn = (q == 0) ? s : (q == 1) ? c : (q == 2) ? -s : -c;
    cs = (q == 0) ? c : (q == 1) ? -s : (q == 2) ? -c : s;
}

template <bool P2>
DI void s5_pass(LAS unsigned char* lds, const Args& a) {
    const int tid = threadIdx.x, lane = tid & 63, w = __builtin_amdgcn_readfirstlane(tid >> 6), r = lane & 31, hh = lane >> 5;
    LAS unsigned char* stl = lds + w * 9216;
    const bf16_t* P0 = (const bf16_t*)(a.ws + WS_P0);
    f32x2* S5ST = (f32x2*)(a.ws + WS_S5ST);
    bf16_t* YG = (bf16_t*)(a.ws + WS_YG);
    const int hhrow = (r >> 2) & 1, irow = (r & 3) + 4 * (r >> 3);
    for (int task = blockIdx.x; task < 1024; task += gridDim.x) {
        const int g8 = task & 7, c = (task >> 3) & 63, bp = task >> 9;
        const int g = g8 * 8 + w;
        const int b = bp * 2 + hh;
        float are[2], aim[2], xr[2], xi[2], a64r[2], a64i[2];
        bf16x8 bfrag[2][2];
#pragma unroll
        for (int ps = 0; ps < 2; ++ps) {
            const int p = r + 32 * ps;
            const f32x4* tp = (const f32x4*)(a.ws + WS_S5TAB) + (size_t)(g * 64 + p) * 2;
            const f32x4 t0 = tp[0], t1 = tp[1];
            are[ps] = t0[0]; aim[ps] = t0[1];
            const float cre = t0[2], cim = t0[3];
            const f32x4* br = (const f32x4*)(a.in[7] + (size_t)(g * 64 + p) * 16 + 8 * hh); const f32x4* bi = (const f32x4*)(a.in[8] + (size_t)(g * 64 + p) * 16 + 8 * hh);
            const f32x4 x0 = br[0], x1 = br[1], y0 = bi[0], y1 = bi[1];
            u32x4 kr, ki;
            kr.x = cvtpk(cre * x0[0] - cim * y0[0], cre * x0[1] - cim * y0[1]); kr.y = cvtpk(cre * x0[2] - cim * y0[2], cre * x0[3] - cim * y0[3]);
            kr.z = cvtpk(cre * x1[0] - cim * y1[0], cre * x1[1] - cim * y1[1]); kr.w = cvtpk(cre * x1[2] - cim * y1[2], cre * x1[3] - cim * y1[3]);
            ki.x = cvtpk(cre * y0[0] + cim * x0[0], cre * y0[1] + cim * x0[1]); ki.y = cvtpk(cre * y0[2] + cim * x0[2], cre * y0[3] + cim * x0[3]);
            ki.z = cvtpk(cre * y1[0] + cim * x1[0], cre * y1[1] + cim * x1[1]); ki.w = cvtpk(cre * y1[2] + cim * x1[2], cre * y1[3] + cim * x1[3]);
            bfrag[0][ps] = __builtin_bit_cast(bf16x8, kr); bfrag[1][ps] = __builtin_bit_cast(bf16x8, ki);
            xr[ps] = 0.f; xi[ps] = 0.f;
            a64r[ps] = t1[0]; a64i[ps] = t1[1];
        }
        bf16x8 cf[4]; f32x4 dsk = {0.f, 0.f, 0.f, 0.f};
        const int tl = lane & 15, kq = lane >> 4;
        if (P2) {
            const f32x2* se = S5ST + ((size_t)(b * 64) * 64 + g) * 64 + r;
#pragma unroll 4
            for (int cc = 0; cc < c; ++cc) {
                const f32x2 e0 = se[(size_t)cc * 4096], e1 = se[(size_t)cc * 4096 + 32];
                const float n0r = a64r[0] * xr[0] - a64i[0] * xi[0] + e0.x, n0i = a64r[0] * xi[0] + a64i[0] * xr[0] + e0.y;
                const float n1r = a64r[1] * xr[1] - a64i[1] * xi[1] + e1.x, n1i = a64r[1] * xi[1] + a64i[1] * xr[1] + e1.y;
                xr[0] = n0r; xi[0] = n0i; xr[1] = n1r; xi[1] = n1i;
            }
#pragma unroll
            for (int kk = 0; kk < 4; ++kk) {
                const size_t off = (size_t)(g * 16 + tl) * 64 + kk * 16 + 4 * kq;
                const f32x4 re = *(const f32x4*)(a.in[9] + off), im = *(const f32x4*)(a.in[10] + off);
                u32x4 pk; pk.x = cvtpk(re[0], -im[0]); pk.y = cvtpk(re[1], -im[1]); pk.z = cvtpk(re[2], -im[2]); pk.w = cvtpk(re[3], -im[3]);
                cf[kk] = __builtin_bit_cast(bf16x8, pk);
            }
            dsk = *(const f32x4*)(a.in[11] + g * 16 + 4 * kq);
        }
        const bf16_t* ubase = P0 + ((size_t)(bp * 2 + hhrow) * SEQ + c * 64 + irow) * 6144 + 3072 + g * 16 + 8 * hh;
        bf16x8 af[4];
#pragma unroll
        for (int rbk = 0; rbk < 4; ++rbk) af[rbk] = *(const bf16x8*)(ubase + (size_t)rbk * 16 * 6144);
        u32x2 usk[4][2];
        if (P2) {
#pragma unroll
            for (int rbk = 0; rbk < 4; ++rbk)
#pragma unroll
                for (int h2 = 0; h2 < 2; ++h2) usk[rbk][h2] = *(const u32x2*)(P0 + ((size_t)(bp * 2 + h2) * SEQ + c * 64 + rbk * 16 + tl) * 6144 + 3072 + g * 16 + 4 * kq);
        }
#pragma unroll
        for (int rbk = 0; rbk < 4; ++rbk) {
            f32x16 Dv[2][2];
#pragma unroll
            for (int part = 0; part < 2; ++part)
#pragma unroll
                for (int ps = 0; ps < 2; ++ps) {
                    f32x16 z;
#pragma unroll
                    for (int i = 0; i < 16; ++i) z[i] = 0.f;
                    Dv[part][ps] = __builtin_amdgcn_mfma_f32_32x32x16_bf16(af[rbk], bfrag[part][ps], z, 0, 0, 0);
                }
#pragma unroll
            for (int i = 0; i < 16; ++i) {
#pragma unroll
                for (int ps = 0; ps < 2; ++ps) {
                    const float nxr = are[ps] * xr[ps] - aim[ps] * xi[ps] + Dv[0][ps][i], nxi = are[ps] * xi[ps] + aim[ps] * xr[ps] + Dv[1][ps][i];
                    xr[ps] = nxr; xi[ps] = nxi;
                    if (P2) *(LAS unsigned*)(stl + hh * 4352 + i * 272 + (r + 32 * ps) * 4) = cvtpk(nxr, nxi);
                }
            }
            if (P2) {
                asm volatile("s_waitcnt lgkmcnt(0)" ::: "memory");
#pragma unroll
                for (int h2 = 0; h2 < 2; ++h2) {
                    f32x4 acc = {0.f, 0.f, 0.f, 0.f};
#pragma unroll
                    for (int kk = 0; kk < 4; ++kk) { const bf16x8 xb = *(LAS const bf16x8*)(stl + h2 * 4352 + tl * 272 + kk * 64 + kq * 16); acc = __builtin_amdgcn_mfma_f32_16x16x32_bf16(cf[kk], xb, acc, 0, 0, 0); }
                    const size_t row = (size_t)(bp * 2 + h2) * SEQ + c * 64 + rbk * 16 + tl;
                    const u32x2 u4 = usk[rbk][h2];
                    float y[4]; y[0] = acc[0] + dsk[0] * bf_lo(u4.x); y[1] = acc[1] + dsk[1] * bf_hi(u4.x); y[2] = acc[2] + dsk[2] * bf_lo(u4.y); y[3] = acc[3] + dsk[3] * bf_hi(u4.y);
#pragma unroll
                    for (int e = 0; e < 4; ++e) { const float v = y[e]; const float z2 = 1.5957691216057308f * (v + 0.044715f * v * v * v); y[e] = v * sigm(z2); }
                    u32x2 o; o.x = cvtpk(y[0], y[1]); o.y = cvtpk(y[2], y[3]);
                    *(u32x2*)(YG + row * 1024 + g * 16 + 4 * kq) = o;
                }
                asm volatile("s_waitcnt lgkmcnt(0)" ::: "memory");
            }
        }
        if (!P2) {
#pragma unroll
            for (int ps = 0; ps < 2; ++ps) { f32x2 e; e.x = xr[ps]; e.y = xi[ps]; S5ST[((size_t)(b * 64 + c) * 64 + g) * 64 + r + 32 * ps] = e; }
        }
    }
}

DI void transpose_item(const float* W, int ld, int K, int nvalid, const float* gk, bf16_t* WT, int kb, int n0, int lane) {
    const int n = n0 + lane, k0 = kb * 32;
    if (n < nvalid) {
        const float* wp = W + (size_t)k0 * ld + n;
        float v[32];
#pragma unroll
        for (int e = 0; e < 32; ++e) v[e] = wp[(size_t)e * ld];
        if (gk) {
#pragma unroll
            for (int e = 0; e < 32; ++e) v[e] *= gk[k0 + e];
        }
        u32x4* dst = (u32x4*)(WT + (size_t)n * K + k0);
#pragma unroll
        for (int q = 0; q < 4; ++q) { u32x4 o; o.x = cvtpk(v[8 * q], v[8 * q + 1]); o.y = cvtpk(v[8 * q + 2], v[8 * q + 3]); o.z = cvtpk(v[8 * q + 4], v[8 * q + 5]); o.w = cvtpk(v[8 * q + 6], v[8 * q + 7]); dst[q] = o; }
    }
}

DI void prologue(LAS unsigned char* lds, const Args& a) {
    const int tid = threadIdx.x, lane = tid & 63, w = __builtin_amdgcn_readfirstlane(tid >> 6);
    const int gw = blockIdx.x * 8 + w, NGW = gridDim.x * 8;
    unsigned char* ws = a.ws;
    constexpr int I0 = 96 * 64, I1 = 16 * 32, I2 = 32 * 64, I3 = 128 * 64, I4 = 64, I5 = 32 * 64, NIT = I0 + I1 + I2 + I3 + I4 + I5;
#pragma unroll 1
    for (int it = gw; it < NIT; it += NGW) {
        int q = it;
        if (q < I0) { transpose_item(a.in[2], 6144, 2048, 6144, a.in[1], (bf16_t*)(ws + WS_W0T), q & 63, (q >> 6) * 64, lane); continue; } q -= I0;
        if (q < I1) { transpose_item(a.in[12], 1024, 1024, 1024, nullptr, (bf16_t*)(ws + WS_WGT), q & 31, (q >> 5) * 64, lane); continue; } q -= I1;
        if (q < I2) { transpose_item(a.in[14], 2048, 2048, 2048, nullptr, (bf16_t*)(ws + WS_WO0T), q & 63, (q >> 6) * 64, lane); continue; } q -= I2;
        if (q < I3) { transpose_item(a.in[16], 8208, 2048, 8192, a.in[15], (bf16_t*)(ws + WS_W1T), q & 63, (q >> 6) * 64, lane); continue; } q -= I3;
        if (q < I4) { transpose_item(a.in[16] + 8192, 8208, 2048, 16, a.in[15], (bf16_t*)(ws + WS_WFT), q, 0, lane); continue; } q -= I4;
        transpose_item(a.in[18], 2048, 2048, 2048, nullptr, (bf16_t*)(ws + WS_WO1T), q & 63, (q >> 6) * 64, lane);
    }
    float* ssq0 = (float*)(ws + WS_SSQ0); bf16_t* XB = (bf16_t*)(ws + WS_XB);
    for (int m = gw; m < M; m += NGW) {
        const f32x4* xr = (const f32x4*)(a.in[0] + (size_t)m * DM) + lane;
        f32x4 v[8]; float s = 0.f;
#pragma unroll
        for (int j = 0; j < 8; ++j) { v[j] = xr[64 * j]; s += (v[j][0] * v[j][0] + v[j][1] * v[j][1]) + (v[j][2] * v[j][2] + v[j][3] * v[j][3]); }
        s = wave_sum(s);
        u32x2* o8 = (u32x2*)(XB + (size_t)m * DM) + lane;
#pragma unroll
        for (int j = 0; j < 8; ++j) { u32x2 o; o.x = cvtpk(v[j][0], v[j][1]); o.y = cvtpk(v[j][2], v[j][3]); o8[64 * j] = o; }
        if (lane == 0) ssq0[m] = s;
    }
    for (int i = blockIdx.x * 512 + tid; i < 4096; i += gridDim.x * 512) {
        const int g = i >> 6;
        const double lr = (double)a.in[4][i], li = (double)a.in[5][i];
        const double dt = exp_d((double)a.in[6][g]);
        const double mag = exp_d(lr * dt);
        double sn, cs; sincos_d(li * dt, sn, cs);
        const double dare = mag * cs, daim = mag * sn;
        const double nr = dare - 1.0, ni = daim, den = lr * lr + li * li;
        double pr = dare, pi = daim;
#pragma unroll
        for (int q = 0; q < 6; ++q) { const double tr = pr * pr - pi * pi, ti = 2.0 * pr * pi; pr = tr; pi = ti; }
        f32x4 t0, t1; t0[0] = (float)dare; t0[1] = (float)daim; t0[2] = (float)((nr * lr + ni * li) / den); t0[3] = (float)((ni * lr - nr * li) / den);
        t1[0] = (float)pr; t1[1] = (float)pi; t1[2] = 0.f; t1[3] = 0.f;
        f32x4* tp = (f32x4*)(ws + WS_S5TAB) + (size_t)i * 2; tp[0] = t0; tp[1] = t1;
    }
    float* ssq1 = (float*)(ws + WS_SSQ1); float* ssq2 = (float*)(ws + WS_SSQ2);
    for (int i = blockIdx.x * 512 + tid; i < M; i += gridDim.x * 512) { ssq1[i] = 0.f; ssq2[i] = 0.f; }
    if (blockIdx.x == 0) for (int i = tid; i < 64 * 64; i += 512) ((unsigned*)(ws + WS_CNT))[i] = 0u;
}

DI void flogit_phase(LAS unsigned char* lds, const Args& a) {
    const int tid = threadIdx.x, lane = tid & 63, w = __builtin_amdgcn_readfirstlane(tid >> 6);
    const bf16_t* X1B = (const bf16_t*)(a.ws + WS_XB); const bf16_t* WFT = (const bf16_t*)(a.ws + WS_WFT);
    const float* ssq1 = (const float*)(a.ws + WS_SSQ1);
    float* cuml = (float*)(a.ws + WS_CUML); float* btot = (float*)(a.ws + WS_BTOT);
    LAS float* part = (LAS float*)lds;
    LAS float* lf = part + 1024;
    const int rg = w & 3, kh = w >> 2, l15 = lane & 15, kq = lane >> 4;
    for (int rb = blockIdx.x; rb < M / 64; rb += gridDim.x) {
        const size_t R0 = (size_t)rb * 64 + rg * 16;
        const bf16_t* ap = X1B + (R0 + l15) * DM + kh * 1024 + 8 * kq;
        const bf16_t* bp = WFT + (size_t)l15 * DM + kh * 1024 + 8 * kq;
        f32x4 acc = {0.f, 0.f, 0.f, 0.f};
#pragma unroll 8
        for (int kk = 0; kk < 32; ++kk) { const bf16x8 af = *(const bf16x8*)(ap + kk * 32), bf = *(const bf16x8*)(bp + kk * 32); acc = __builtin_amdgcn_mfma_f32_16x16x32_bf16(af, bf, acc, 0, 0, 0); }
        if (kh == 1) {
#pragma unroll
            for (int e = 0; e < 4; ++e) part[rg * 256 + (4 * kq + e) * 16 + l15] = acc[e];
        }
        __syncthreads();
        if (kh == 0) {
            const float bfg = a.in[17][l15];
#pragma unroll
            for (int e = 0; e < 4; ++e) {
                const int tok = 4 * kq + e; const size_t row = R0 + tok;
                const float rs = 1.f / sqrtf(ssq1[row] * (1.f / 2048.f) + 1e-6f);
                const float f = (acc[e] + part[rg * 256 + tok * 16 + l15]) * rs + bfg;
                const float ls = fminf(f, 0.f) - log1pf(__expf(-fabsf(f)));
                lf[(rg * 16 + tok) * 16 + l15] = ls;
            }
        }
        __syncthreads();
        if (tid < 16) {
            const int bb = rb >> 6, t0 = (rb & 63) * 64; float cum = 0.f;
            float* cp = cuml + (size_t)(bb * 16 + tid) * SEQ + t0;
            for (int i = 0; i < 64; ++i) { cum += lf[i * 16 + tid]; cp[i] = cum; }
            btot[rb * 16 + tid] = cum;
        }
        __syncthreads();
    }
}

DI void final_norm(const Args& a) {
    const int tid = threadIdx.x, lane = tid & 63, w = tid >> 6;
    const int gw = blockIdx.x * 8 + w, NGW = gridDim.x * 8;
    const float* ssq2 = (const float*)(a.ws + WS_SSQ2);
    const f32x4* gp = (const f32x4*)a.in[19] + lane;
    for (int m = gw; m < M; m += NGW) {
        const float rs = 1.f / sqrtf(ssq2[m] * (1.f / 2048.f) + 1e-6f);
        f32x4* xr = (f32x4*)(a.out + (size_t)m * DM) + lane;
#pragma unroll
        for (int j = 0; j < 8; ++j) { f32x4 v = xr[64 * j]; const f32x4 g = gp[64 * j]; v = v * rs * g; xr[64 * j] = v; }
    }
}

#define XB_TMO      128
#define XB_XCNT(j)  (256  + 64 * (j))
#define XB_XSUB(j)  (1280 + 64 * (j))
#define XB_XGEN(j)  (2304 + 64 * (j))
#define XB_TOP      3328
#define XB_TOPGEN   3392
#define XCD_BAR_WORDS 3456
#define XB_SPIN_CAP (1u << 18)

__device__ __forceinline__ unsigned xb_ld(unsigned* p)              { return __hip_atomic_load(p, __ATOMIC_RELAXED, __HIP_MEMORY_SCOPE_AGENT); }
__device__ __forceinline__ unsigned xb_add(unsigned* p, unsigned v) { return __hip_atomic_fetch_add(p, v, __ATOMIC_RELAXED, __HIP_MEMORY_SCOPE_AGENT); }
__device__ __forceinline__ unsigned xb_xcc_id() { return (unsigned)__builtin_amdgcn_s_getreg((3 << 11) | 20) & 0xFu; }
#define XB_SPIN(cond, bar) do { unsigned _sp = 0; while (cond) { __builtin_amdgcn_s_sleep(1); \
    if ((++_sp & 255u) == 0u) { if (xb_ld(&(bar)[XB_TMO])) break; if (_sp > XB_SPIN_CAP) { atomicAdd(&(bar)[XB_TMO], 1u); break; } } } } while (0)

struct XcdBarrier {
    unsigned* bar; unsigned x;
    volatile LAS unsigned* st;
};

__device__ __forceinline__ XcdBarrier xcd_barrier_post(unsigned* bar, volatile LAS unsigned* st) {
    XcdBarrier b; b.bar = bar; b.x = xb_xcc_id(); b.st = st;
    if (threadIdx.x == 0) (void)xb_add(&bar[XB_XCNT(b.x)], 1u);
    return b;
}
__device__ __forceinline__ void xcd_barrier_complete(unsigned* bar, unsigned x, unsigned& nloc, unsigned& nx) {
    const unsigned G = gridDim.x * gridDim.y * gridDim.z;
    unsigned sum, cnt, mine, sp = 0u;
    for (;;) {
        sum = 0u; cnt = 0u; mine = 0u;
#pragma unroll
        for (unsigned j = 0; j < 16; ++j) { const unsigned c = xb_ld(&bar[XB_XCNT(j)]); sum += c; cnt += (c > 0u) ? 1u : 0u; mine = (j == x) ? c : mine; }
        if (sum == G) break;
        __builtin_amdgcn_s_sleep(1);
        if ((++sp & 255u) == 0u) { if (xb_ld(&bar[XB_TMO])) break; if (sp > XB_SPIN_CAP) { atomicAdd(&bar[XB_TMO], 1u); break; } }
    }
    nloc = mine > 0u ? mine : 1u; nx = cnt > 0u ? cnt : 1u;
}

__device__ __forceinline__ void xcd_barrier(const XcdBarrier& b) {
    asm volatile("s_waitcnt vmcnt(0)" ::: "memory");
    __syncthreads();
    if (threadIdx.x == 0) {
        unsigned* bar = b.bar;
        __builtin_amdgcn_s_waitcnt(0);
        unsigned nloc = b.st[0], nx = b.st[1];
        if (nloc == 0u) { xcd_barrier_complete(bar, b.x, nloc, nx); b.st[0] = nloc; b.st[1] = nx; }
        const unsigned old = xb_add(&bar[XB_XSUB(b.x)], 1u);
        const unsigned gen = old / nloc;
        if (old + 1u == (gen + 1u) * nloc) {
            __builtin_amdgcn_fence(__ATOMIC_RELEASE, "agent");
            asm volatile("s_waitcnt vmcnt(0)" ::: "memory");
            const unsigned og = xb_add(&bar[XB_TOP], 1u);
            const unsigned tg = og / nx;
            if (og + 1u == (tg + 1u) * nx) xb_add(&bar[XB_TOPGEN], 1u);
            else XB_SPIN(xb_ld(&bar[XB_TOPGEN]) == tg, bar);
            __builtin_amdgcn_fence(__ATOMIC_ACQUIRE, "agent");
            xb_add(&bar[XB_XGEN(b.x)], 1u);
            asm volatile("s_waitcnt vmcnt(0)" ::: "memory");
        } else {
            XB_SPIN(xb_ld(&bar[XB_XGEN(b.x)]) == gen, bar);
            __builtin_amdgcn_fence(__ATOMIC_ACQUIRE, "agent");
            asm volatile("s_waitcnt vmcnt(0)" ::: "memory");
        }
    }
    __syncthreads();
}

__global__ void __launch_bounds__(512, 2) mega(Args a) {
    extern __shared__ __attribute__((aligned(16))) unsigned char lds_raw[];
    LAS unsigned char* lds = (LAS unsigned char*)lds_raw;
    cg::grid_group grid = cg::this_grid();
    if (threadIdx.x < 4) ((LAS unsigned*)(lds + LDS_MISC))[threadIdx.x] = 0u;
    __syncthreads();
    unsigned* barw = (unsigned*)(a.ws + WS_BAR);
    XcdBarrier xbar; xbar.bar = barw; xbar.x = 0; xbar.st = (volatile LAS unsigned*)(lds + LDS_MISC);
    const int lo = a.ph_lo, hi = a.ph_hi;
    const int G = gridDim.x, bx = blockIdx.x;
    const int vcu = (G % 8 == 0) ? (bx % 8) * (G / 8) + bx / 8 : bx;
    unsigned char* ws = a.ws;
#define IN(k) (lo <= (k) && (k) < hi)
#define SEAM(k) do { if (IN(k) && IN((k) + 1)) xcd_barrier(xbar); } while (0)
    if (lo < 0) grid.sync();
    xbar = xcd_barrier_post(barw, (volatile LAS unsigned*)(lds + LDS_MISC));
    if (IN(0)) { REP(0) prologue(lds, a); }
    SEAM(0);
    if (IN(1)) {
        pg8::Gemm g{(const bf16_t*)(ws + WS_XB), (const bf16_t*)(ws + WS_W0T), M, 6144, 2048}; pg8::StaticOrder S; S.init(M, 6144, G, bx);
        pg8::EpiProj E{(bf16_t*)(ws + WS_P0), 6144, (const float*)(ws + WS_SSQ0), 1024, 0.125f * LOG2E};
        REP(1) pg8::gemm_phase<pg8::EpiProj, pg8::StaticOrder, true, true>(lds, g, S, E);
    }
    SEAM(1);
    if (IN(2)) {
        const bf16_t* P0 = (const bf16_t*)(ws + WS_P0);
        int prev_h = -1;
        REP(20) for (int u = vcu; u < 1024; u += G) {
            const int bh = u >> 4, qb = u & 15;
            attn_unit<64, 0>(lds, P0, 6144, 0, 1024, 2048, P0, 6144, 4096, (bf16_t*)(ws + WS_MIX), 2048, 0, bh >> 4, bh & 15, qb, a.in[3], nullptr, prev_h == (bh & 15));
            prev_h = bh & 15;
        }
        REP(21) s5_pass<false>(lds, a);
    }
    SEAM(2);
    if (IN(3)) { REP(3) s5_pass<true>(lds, a); }
    SEAM(3);
    if (IN(4)) {
        pg8::Gemm g{(const bf16_t*)(ws + WS_YG), (const bf16_t*)(ws + WS_WGT), M, 1024, 1024}; pg8::StaticOrder S; S.init(M, 1024, G, bx);
        pg8::EpiGlu E{(const bf16_t*)(ws + WS_YG), 1024, (const bf16_t*)(ws + WS_P0) + 5120, 6144, a.in[13], (bf16_t*)(ws + WS_MIX) + 1024, 2048};
        REP(4) pg8::gemm_phase<pg8::EpiGlu, pg8::StaticOrder, true, true>(lds, g, S, E);
    }
    SEAM(4);
    if (IN(5)) {
        pg8::Gemm g{(const bf16_t*)(ws + WS_MIX), (const bf16_t*)(ws + WS_WO0T), M, 2048, 2048}; pg8::StaticOrder S; S.init(M, 2048, G, bx);
        pg8::EpiRes E{a.in[0], nullptr, nullptr, (bf16_t*)(ws + WS_XB), (float*)(ws + WS_SSQ1)};
        if (DUP == 5) { pg8::EpiRes E2{a.in[0], nullptr, nullptr, (bf16_t*)(ws + WS_XB), (float*)(ws + 262144)}; pg8::gemm_phase<pg8::EpiRes, pg8::StaticOrder, true, true>(lds, g, S, E2); }
        pg8::gemm_phase<pg8::EpiRes, pg8::StaticOrder, true, true>(lds, g, S, E);
    }
    SEAM(5);
    if (IN(6)) {
        REP(60) flogit_phase(lds, a);
        pg8::Gemm g{(const bf16_t*)(ws + WS_XB), (const bf16_t*)(ws + WS_W1T), M, 8192, 2048}; pg8::StaticOrder S; S.init(M, 8192, G, bx);
        pg8::EpiProj E{(bf16_t*)(ws + WS_P1), 8192, (const float*)(ws + WS_SSQ1), 2048, 0.08838834764831845f * LOG2E};
        REP(6) pg8::gemm_phase<pg8::EpiProj, pg8::StaticOrder, true, true>(lds, g, S, E);
    }
    SEAM(6);
    if (IN(7)) {
        const bf16_t* P1 = (const bf16_t*)(ws + WS_P1);
        REP(7) for (int pi = vcu; pi < 512; pi += G) {
            const int bh = pi >> 3, x = pi & 7;
            attn_unit<128, 1>(lds, P1, 8192, 0, 2048, 4096, P1, 8192, 6144, (bf16_t*)(ws + WS_OG), 2048, 0, bh >> 4, bh & 15, 15 - x, (const float*)(ws + WS_CUML), (const float*)(ws + WS_BTOT), false);
            attn_unit<128, 1>(lds, P1, 8192, 0, 2048, 4096, P1, 8192, 6144, (bf16_t*)(ws + WS_OG), 2048, 0, bh >> 4, bh & 15, x, (const float*)(ws + WS_CUML), (const float*)(ws + WS_BTOT), true);
        }
    }
    SEAM(7);
    if (IN(8)) {
        pg8::Gemm g{(const bf16_t*)(ws + WS_OG), (const bf16_t*)(ws + WS_WO1T), M, 2048, 2048}; pg8::PanelOrder S; S.init(M, 2048, G, bx);
        if (G % 8 == 0) {
            pg8::EpiResNorm E{(const bf16_t*)(ws + WS_XB), a.out, (float*)(ws + WS_SSQ2), (unsigned*)(ws + WS_CNT), a.in[19]};
            pg8::gemm_phase<pg8::EpiResNorm, pg8::PanelOrder, true, true>(lds, g, S, E);
        } else {
            pg8::EpiRes E{nullptr, (const bf16_t*)(ws + WS_XB), a.out, nullptr, (float*)(ws + WS_SSQ2)};
            pg8::gemm_phase<pg8::EpiRes, pg8::PanelOrder, true, true>(lds, g, S, E);
            xcd_barrier(xbar);
            final_norm(a);
        }
    }
    if (DUP == 100) { for (int q = 0; q < 9; ++q) xcd_barrier(xbar); }
#undef IN
#undef SEAM
}

extern "C" void kernel_launch(void* const* d_in, const int* in_sizes, int n_in, void* d_out, int out_size, void* d_ws, size_t ws_size, hipStream_t stream) {
    static int grid = 0;
    if (grid == 0) {
        if (n_in != 20 || out_size != M * DM || ws_size < WS_END) { fprintf(stderr, "kernel_launch: unexpected shapes (n_in %d out %d ws %zu)\n", n_in, out_size, ws_size); grid = -1; return; }
        int dev = 0, cus = 0, per_cu = 0;
        (void)hipGetDevice(&dev);
        (void)hipDeviceGetAttribute(&cus, hipDeviceAttributeMultiprocessorCount, dev);
        (void)hipFuncSetAttribute((const void*)mega, hipFuncAttributeMaxDynamicSharedMemorySize, LDS_BYTES);
        (void)hipOccupancyMaxActiveBlocksPerMultiprocessor(&per_cu, (const void*)mega, 512, LDS_BYTES);
        if (per_cu < 1) per_cu = 1;
        grid = cus * per_cu;
        (void)hipGetLastError();
    }
    if (grid < 0) return;
    Args a{};
    for (int i = 0; i < 20; ++i) a.in[i] = (const float*)d_in[i];
    a.out = (float*)d_out; a.ws = (unsigned char*)d_ws; a.ph_lo = 0; a.ph_hi = 10;
    (void)hipMemsetAsync((unsigned char*)d_ws + WS_BAR, 0, XCD_BAR_WORDS * 4, stream);
    void* args[] = {&a};
    hipError_t e = hipLaunchCooperativeKernel((const void*)mega, dim3(grid), dim3(512), args, LDS_BYTES, stream);
    if (e != hipSuccess) fprintf(stderr, "cooperative launch failed: %s (grid %d)\n", hipGetErrorString(e), grid);
}
```

```cpp
#include <hip/hip_runtime.h>
#include <hip/hip_cooperative_groups.h>
#include <cstdio>
#include <cstdint>
namespace cg = cooperative_groups;
#define DI __device__ __forceinline__
#define LAS __attribute__((address_space(3)))
namespace pg8 {
#define PG8_LAS __attribute__((address_space(3)))
typedef unsigned short bf16_t;
typedef short bf16x8 __attribute__((ext_vector_type(8)));
typedef float f32x4 __attribute__((ext_vector_type(4)));
typedef unsigned u32x4 __attribute__((ext_vector_type(4)));
constexpr int BM = 256, BK = 64, HALF = 128, HTB = HALF * BK * 2  , STAGE_BYTES = 8 * HTB, NXCD = 8, WGM = 8;

__host__ __device__ __forceinline__ int lds_byte(int r, int c) { const int st = (r >> 4) * 2 + (c >> 5), rr = r & 15, cc = c & 31, ob = rr * 64 + cc * 2; return st * 1024 + (ob ^ (((ob >> 9) & 1) << 5)); }
__host__ __device__ __forceinline__ void stage_rc(int b, int& R, int& C) { const int st = b / 1024, sb = b % 1024, swz = sb ^ (((sb >> 9) & 1) << 5); R = (st >> 1) * 16 + swz / 64; C = (st & 1) * 32 + (swz % 64) / 2; }
__host__ __device__ __forceinline__ int perm32(int rho) { const int n = rho >> 4, i = rho & 15; return 8 * (i >> 2) + 4 * n + (i & 3); }

struct Unit { int pm, pn; };
struct Gemm { const bf16_t* A; const bf16_t* Bt; int M, N, K; };

struct StaticOrder {
    int nM, nN, nwg, G, c;
    __host__ __device__ void init(int M, int N, int G_, int c_) { nM = M / BM; nN = N / BM; nwg = nM * nN; G = G_; c = c_; }
    __host__ __device__ bool next(int i, Unit& u) const {
        const long L = (long)i * G + c; if (L >= nwg) return false;
        int wgid = (int)L; { const int q = nwg / NXCD, r = nwg % NXCD, xcd = wgid % NXCD, off = wgid / NXCD; wgid = (xcd < r ? xcd * (q + 1) : r * (q + 1) + (xcd - r) * q) + off; }
        const int nig = WGM * nN, gid = wgid / nig, fm = gid * WGM, gsz = (nM - fm) < WGM ? (nM - fm) : WGM;
        u.pm = fm + ((wgid % nig) % gsz); u.pn = (wgid % nig) / gsz; return true;
    }
    __device__ __forceinline__ void a_ready(const Unit&) const {}
    __device__ __forceinline__ void done(const Unit&) const {}
};


typedef unsigned u32x2 __attribute__((ext_vector_type(2)));
typedef float f32x2 __attribute__((ext_vector_type(2)));
typedef __bf16 bf16x2_t __attribute__((ext_vector_type(2)));
__device__ __forceinline__ unsigned cvtpk(float lo, float hi) { f32x2 v = {lo, hi}; bf16x2_t b = __builtin_convertvector(v, bf16x2_t); return __builtin_bit_cast(unsigned, b); }
__device__ __forceinline__ float bf_lo(unsigned u) { return __builtin_bit_cast(float, u << 16); }
__device__ __forceinline__ float bf_hi(unsigned u) { return __builtin_bit_cast(float, u & 0xffff0000u); }
__device__ __forceinline__ float sigm(float v) { return __builtin_amdgcn_rcpf(1.f + __expf(-v)); }

struct EpiProj {
    static constexpr bool PERM = true, AFTER_DRAIN = false;
    bf16_t* O; int ldc; const float* ssq; int qcols; float qscale;
    __device__ __forceinline__ void operator()(const f32x4 (&acc)[2][2][4][2], const Unit& u, int wr, int wc, int fr, int fq) const {
        const int row0 = u.pm * BM + wr * 64 + fr, col0 = u.pn * BM + wc * 32 + 8 * fq;
        const float cs = (u.pn * BM < qcols) ? qscale : 1.f;
#pragma unroll
        for (int ai = 0; ai < 2; ++ai)
#pragma unroll
            for (int m = 0; m < 4; ++m) {
                const int row = row0 + ai * HALF + m * 16;
                const float rs = cs / sqrtf(ssq[row] * (1.f / 2048.f) + 1e-6f);
                bf16_t* rowp = O + (size_t)row * ldc + col0;
#pragma unroll
                for (int bj = 0; bj < 2; ++bj) {
                    const f32x4 v0 = acc[ai][bj][m][0] * rs, v1 = acc[ai][bj][m][1] * rs;
                    u32x4 w; w.x = cvtpk(v0[0], v0[1]); w.y = cvtpk(v0[2], v0[3]); w.z = cvtpk(v1[0], v1[1]); w.w = cvtpk(v1[2], v1[3]);
                    *(u32x4*)(rowp + bj * HALF) = w;
                }
            }
    }
};

struct EpiGlu {
    static constexpr bool PERM = true, AFTER_DRAIN = false;
    const bf16_t* Y; int ldy; const bf16_t* ZB; int ldz; const float* bias; bf16_t* O; int ldo;
    __device__ __forceinline__ void operator()(const f32x4 (&acc)[2][2][4][2], const Unit& u, int wr, int wc, int fr, int fq) const {
        const int row0 = u.pm * BM + wr * 64 + fr, col0 = u.pn * BM + wc * 32 + 8 * fq;
#pragma unroll
        for (int ai = 0; ai < 2; ++ai)
#pragma unroll
            for (int m = 0; m < 4; ++m) {
                const int row = row0 + ai * HALF + m * 16;
#pragma unroll
                for (int bj = 0; bj < 2; ++bj) {
                    const int c = col0 + bj * HALF;
                    const u32x4 y8 = *(const u32x4*)(Y + (size_t)row * ldy + c), z8 = *(const u32x4*)(ZB + (size_t)row * ldz + c);
                    const f32x4 b0 = *(const f32x4*)(bias + c), b1 = *(const f32x4*)(bias + c + 4);
                    const f32x4 v0 = acc[ai][bj][m][0] + b0, v1 = acc[ai][bj][m][1] + b1;
                    float o[8];
#pragma unroll
                    for (int e = 0; e < 8; ++e) {
                        const unsigned yy = y8[e >> 1], zz = z8[e >> 1];
                        const float y = (e & 1) ? bf_hi(yy) : bf_lo(yy), z = (e & 1) ? bf_hi(zz) : bf_lo(zz);
                        const float v = e < 4 ? v0[e & 3] : v1[e & 3];
                        o[e] = y * sigm(v) * z * sigm(z);
                    }
                    u32x4 w; w.x = cvtpk(o[0], o[1]); w.y = cvtpk(o[2], o[3]); w.z = cvtpk(o[4], o[5]); w.w = cvtpk(o[6], o[7]);
                    *(u32x4*)(O + (size_t)row * ldo + c) = w;
                }
            }
    }
};

struct EpiRes {
    static constexpr bool PERM = true, AFTER_DRAIN = false;
    const float* R; const bf16_t* RB; float* OF; bf16_t* OB; float* ssq;
    __device__ __forceinline__ void operator()(const f32x4 (&acc)[2][2][4][2], const Unit& u, int wr, int wc, int fr, int fq) const {
        const int row0 = u.pm * BM + wr * 64 + fr, col0 = u.pn * BM + wc * 32 + 8 * fq;
#pragma unroll
        for (int ai = 0; ai < 2; ++ai) {
            f32x4 rr[4][2][2];
#pragma unroll
            for (int m = 0; m < 4; ++m)
#pragma unroll
                for (int bj = 0; bj < 2; ++bj) {
                    const size_t off = (size_t)(row0 + ai * HALF + m * 16) * 2048 + col0 + bj * HALF;
                    if (RB) { const u32x4 h = *(const u32x4*)(RB + off);
                        rr[m][bj][0] = (f32x4){bf_lo(h.x), bf_hi(h.x), bf_lo(h.y), bf_hi(h.y)}; rr[m][bj][1] = (f32x4){bf_lo(h.z), bf_hi(h.z), bf_lo(h.w), bf_hi(h.w)}; }
                    else { rr[m][bj][0] = *(const f32x4*)(R + off); rr[m][bj][1] = *(const f32x4*)(R + off + 4); }
                }
            __builtin_amdgcn_sched_barrier(0);
#pragma unroll
            for (int m = 0; m < 4; ++m) {
                const int row = row0 + ai * HALF + m * 16;
                float s = 0.f;
#pragma unroll
                for (int bj = 0; bj < 2; ++bj) {
                    const size_t off = (size_t)row * 2048 + col0 + bj * HALF;
                    const f32x4 v0 = acc[ai][bj][m][0] + rr[m][bj][0], v1 = acc[ai][bj][m][1] + rr[m][bj][1];
                    if (OF) { *(f32x4*)(OF + off) = v0; *(f32x4*)(OF + off + 4) = v1; }
                    if (OB) { u32x4 w; w.x = cvtpk(v0[0], v0[1]); w.y = cvtpk(v0[2], v0[3]); w.z = cvtpk(v1[0], v1[1]); w.w = cvtpk(v1[2], v1[3]); *(u32x4*)(OB + off) = w; }
                    s += (v0[0] * v0[0] + v0[1] * v0[1]) + (v0[2] * v0[2] + v0[3] * v0[3]) + (v1[0] * v1[0] + v1[1] * v1[1]) + (v1[2] * v1[2] + v1[3] * v1[3]);
                }
                s += __shfl_xor(s, 16); s += __shfl_xor(s, 32);
                if (fq == 0) atomicAdd(ssq + row, s);
            }
            __builtin_amdgcn_sched_barrier(0);
        }
    }
};

struct EpiResNorm {
    static constexpr bool PERM = true, AFTER_DRAIN = false;
    const bf16_t* RB; float* OF; float* ssq; unsigned* cnt; const float* gfin;
    __device__ __forceinline__ void operator()(f32x4 (&acc)[2][2][4][2], const Unit& u, int wr, int wc, int fr, int fq) const {
        const int row0 = u.pm * BM + wr * 64 + fr, col0 = u.pn * BM + wc * 32 + 8 * fq;
#pragma unroll
        for (int ai = 0; ai < 2; ++ai) {
            f32x4 rr[4][2][2];
#pragma unroll
            for (int m = 0; m < 4; ++m)
#pragma unroll
                for (int bj = 0; bj < 2; ++bj) {
                    const size_t off = (size_t)(row0 + ai * HALF + m * 16) * 2048 + col0 + bj * HALF;
                    const u32x4 h = *(const u32x4*)(RB + off);
                    rr[m][bj][0] = (f32x4){bf_lo(h.x), bf_hi(h.x), bf_lo(h.y), bf_hi(h.y)}; rr[m][bj][1] = (f32x4){bf_lo(h.z), bf_hi(h.z), bf_lo(h.w), bf_hi(h.w)};
                }
            __builtin_amdgcn_sched_barrier(0);
#pragma unroll
            for (int m = 0; m < 4; ++m) {
                const int row = row0 + ai * HALF + m * 16;
                float s = 0.f;
#pragma unroll
                for (int bj = 0; bj < 2; ++bj) {
                    const f32x4 v0 = acc[ai][bj][m][0] + rr[m][bj][0], v1 = acc[ai][bj][m][1] + rr[m][bj][1];
                    acc[ai][bj][m][0] = v0; acc[ai][bj][m][1] = v1;
                    s += (v0[0] * v0[0] + v0[1] * v0[1]) + (v0[2] * v0[2] + v0[3] * v0[3]) + (v1[0] * v1[0] + v1[1] * v1[1]) + (v1[2] * v1[2] + v1[3] * v1[3]);
                }
                s += __shfl_xor(s, 16); s += __shfl_xor(s, 32);
                if (fq == 0) atomicAdd(ssq + row, s);
            }
            __builtin_amdgcn_sched_barrier(0);
        }
        asm volatile("s_waitcnt vmcnt(0)" ::: "memory");
        __syncthreads();
        if (threadIdx.x == 0) {
            unsigned* c = cnt + 64 * u.pm;
            (void)__hip_atomic_fetch_add(c, 1u, __ATOMIC_RELAXED, __HIP_MEMORY_SCOPE_AGENT);
            unsigned sp = 0;
            while (__hip_atomic_load(c, __ATOMIC_RELAXED, __HIP_MEMORY_SCOPE_AGENT) < 8u) { __builtin_amdgcn_s_sleep(1); if (++sp > (1u << 22)) break; }
        }
        __syncthreads();
#pragma unroll
        for (int ai = 0; ai < 2; ++ai)
#pragma unroll
            for (int m = 0; m < 4; ++m) {
                const int row = row0 + ai * HALF + m * 16;
                const float rs = 1.f / sqrtf(__hip_atomic_load(ssq + row, __ATOMIC_RELAXED, __HIP_MEMORY_SCOPE_AGENT) * (1.f / 2048.f) + 1e-6f);
#pragma unroll
                for (int bj = 0; bj < 2; ++bj) {
                    const size_t off = (size_t)row * 2048 + col0 + bj * HALF;
                    const f32x4 g0 = *(const f32x4*)(gfin + col0 + bj * HALF), g1 = *(const f32x4*)(gfin + col0 + bj * HALF + 4);
                    *(f32x4*)(OF + off) = acc[ai][bj][m][0] * rs * g0; *(f32x4*)(OF + off + 4) = acc[ai][bj][m][1] * rs * g1;
                }
            }
    }
};

struct PanelOrder {
    int nwg, G, c, nN;
    __host__ __device__ void init(int M, int N, int G_, int c_) { nN = N / BM; nwg = (M / BM) * nN; G = G_; c = c_; }
    __host__ __device__ bool next(int i, Unit& u) const { const long L = (long)i * G + c; if (L >= nwg) return false; u.pm = (int)(L / nN); u.pn = (int)(L % nN); return true; }
    __device__ __forceinline__ void a_ready(const Unit&) const {}
    __device__ __forceinline__ void done(const Unit&) const {}
};
template <class Epi, class Sched, bool ALIGN_EPI = false, bool SP2 = false>
__device__ __forceinline__ void gemm_phase(PG8_LAS unsigned char* lds, const Gemm g, const Sched& S, const Epi& E) {
    const int tid = threadIdx.x, wid = __builtin_amdgcn_readfirstlane(tid >> 6), lane = tid & 63, wr = wid >> 2, wc = wid & 3, fr = lane & 15, fq = lane >> 4;
    const int K = g.K, nt = K / BK;
    unsigned voffA[2], voffB[2];
#pragma unroll
    for (int i = 0; i < 2; ++i) { int R, C; stage_rc(tid * 16 + i * 8192, R, C); const int Rb = Epi::PERM ? ((R & ~31) + perm32(R & 31)) : R;
        voffA[i] = (unsigned)(R * K + C) * 2u; voffB[i] = (unsigned)(Rb * K + C) * 2u; }
    const size_t kstep = (size_t)(BK * 2);
    const size_t hstep = (size_t)HALF * K * 2;
    const size_t tstep = 2 * hstep;
    const unsigned ldsw = (unsigned)wid * 1024u;
    const int aoff = lds_byte(wr * 64 + fr, fq * 8), boff = lds_byte(wc * 32 + fr, fq * 8);
#define PG8_SA(b, h) (((b) * 2 + (h)) * HTB)
#define PG8_SB(b, h) ((4 + (b) * 2 + (h)) * HTB)
#define PG8_STAGE(bufoff, gbase, voff) do { _Pragma("unroll") for (int _i = 0; _i < 2; ++_i) \
        __builtin_amdgcn_global_load_lds((const unsigned*)((const char*)(gbase) + (voff)[_i]), (PG8_LAS unsigned*)(lds + (bufoff) + ldsw + _i * 8192), 16, 0, 0); } while (0)
#define PG8_LDA(dst, b, h) do { _Pragma("unroll") for (int m = 0; m < 4; ++m) _Pragma("unroll") for (int k = 0; k < 2; ++k) dst[m][k] = *(const PG8_LAS bf16x8*)(lds + PG8_SA(b, h) + aoff + m * 2048 + k * 1024); } while (0)
#define PG8_LDB(dst, b, h) do { _Pragma("unroll") for (int n = 0; n < 2; ++n) _Pragma("unroll") for (int k = 0; k < 2; ++k) dst[n][k] = *(const PG8_LAS bf16x8*)(lds + PG8_SB(b, h) + boff + n * 2048 + k * 1024); } while (0)
#define PG8_MMA(ai, bj, At, Bt) do { __builtin_amdgcn_s_setprio(1); _Pragma("unroll") for (int m = 0; m < 4; ++m) _Pragma("unroll") for (int n = 0; n < 2; ++n) _Pragma("unroll") for (int k = 0; k < 2; ++k) \
        acc[ai][bj][m][n] = __builtin_amdgcn_mfma_f32_16x16x32_bf16(Bt[n][k], At[m][k], acc[ai][bj][m][n], 0, 0, 0); __builtin_amdgcn_s_setprio(0); } while (0)
#define PG8_WAIT_V(n) asm volatile("s_waitcnt vmcnt(" #n ")" ::: "memory")
#define PG8_WAIT_L(n) asm volatile("s_waitcnt lgkmcnt(" #n ")" ::: "memory")
#define PG8_BAR __builtin_amdgcn_s_barrier()
#define PG8_SCHED __builtin_amdgcn_sched_barrier(0)
    Unit cur, nxt; int ui = 0;
    if (!S.next(0, cur)) return;
    f32x4 acc[2][2][4][2];
#pragma unroll
    for (int a = 0; a < 2; ++a)
#pragma unroll
        for (int b = 0; b < 2; ++b)
#pragma unroll
            for (int m = 0; m < 4; ++m)
#pragma unroll
                for (int n = 0; n < 2; ++n) acc[a][b][m][n] = (f32x4){0.f, 0.f, 0.f, 0.f};
    bf16x8 At[4][2], B0[2][2], B1[2][2];
    const char* cA = (const char*)g.A + (size_t)cur.pm * tstep; const char* cB = (const char*)g.Bt + (size_t)cur.pn * tstep;
    S.a_ready(cur);
    if constexpr (SP2) {
        PG8_STAGE(PG8_SB(0, 0), cB, voffB); PG8_STAGE(PG8_SB(0, 1), cB + hstep, voffB); PG8_STAGE(PG8_SA(0, 0), cA, voffA); PG8_STAGE(PG8_SA(0, 1), cA + hstep, voffA);
        if (wr == 1) PG8_BAR;
        PG8_WAIT_V(2); PG8_BAR;
        PG8_STAGE(PG8_SB(1, 0), cB + kstep, voffB); PG8_STAGE(PG8_SA(1, 0), cA + kstep, voffA); PG8_STAGE(PG8_SB(1, 1), cB + hstep + kstep, voffB);
        PG8_WAIT_V(6); PG8_BAR;
    } else {
        PG8_STAGE(PG8_SB(0, 0), cB, voffB); PG8_STAGE(PG8_SA(0, 0), cA, voffA); PG8_STAGE(PG8_SB(0, 1), cB + hstep, voffB); PG8_STAGE(PG8_SA(0, 1), cA + hstep, voffA);
        if (wr == 1) PG8_BAR;
        PG8_WAIT_V(4); PG8_BAR;
        PG8_STAGE(PG8_SB(1, 0), cB + kstep, voffB); PG8_STAGE(PG8_SA(1, 0), cA + kstep, voffA); PG8_STAGE(PG8_SB(1, 1), cB + hstep + kstep, voffB);
        PG8_WAIT_V(6); PG8_BAR;
    }
    for (;;) {
        const bool has_next = S.next(ui + 1, nxt);
        const char* nA = has_next ? (const char*)g.A + (size_t)nxt.pm * tstep : cA; const char* nB = has_next ? (const char*)g.Bt + (size_t)nxt.pn * tstep : cB;
        for (int t = 0; t < nt; t += 2) {
            const bool last = (t == nt - 2);
            const char* a1 = cA + (size_t)(t + 1) * kstep;
            const char* a2 = last ? nA : cA + (size_t)(t + 2) * kstep; const char* b2 = last ? nB : cB + (size_t)(t + 2) * kstep;
            const char* a3 = a2 + kstep; const char* b3 = b2 + kstep;
            if (last && has_next) S.a_ready(nxt);
            if constexpr (SP2) {
            PG8_LDB(B0, 0, 0); PG8_LDB(B1, 0, 1); PG8_SCHED; PG8_LDA(At, 0, 0); PG8_STAGE(PG8_SA(1, 1), a1 + hstep, voffA);
            PG8_WAIT_V(8); PG8_WAIT_L(0); PG8_BAR; PG8_MMA(0, 0, At, B0); PG8_MMA(0, 1, At, B1); PG8_BAR; PG8_SCHED;
            PG8_LDA(At, 0, 1); PG8_STAGE(PG8_SB(0, 0), b2, voffB); PG8_STAGE(PG8_SB(0, 1), b2 + hstep, voffB); PG8_STAGE(PG8_SA(0, 0), a2, voffA);
            PG8_WAIT_V(8); PG8_WAIT_L(0); PG8_BAR; PG8_MMA(1, 0, At, B0); PG8_MMA(1, 1, At, B1); PG8_BAR; PG8_SCHED;
            PG8_LDB(B0, 1, 0); PG8_LDB(B1, 1, 1); PG8_SCHED; PG8_LDA(At, 1, 0); PG8_STAGE(PG8_SA(0, 1), a2 + hstep, voffA);
            PG8_WAIT_V(8); PG8_WAIT_L(0); PG8_BAR; PG8_MMA(0, 0, At, B0); PG8_MMA(0, 1, At, B1); PG8_BAR; PG8_SCHED;
            PG8_LDA(At, 1, 1); PG8_STAGE(PG8_SB(1, 0), b3, voffB); PG8_STAGE(PG8_SB(1, 1), b3 + hstep, voffB); PG8_STAGE(PG8_SA(1, 0), a3, voffA);
            PG8_WAIT_V(8); PG8_WAIT_L(0); PG8_BAR; PG8_MMA(1, 0, At, B0); PG8_MMA(1, 1, At, B1); PG8_BAR; PG8_SCHED;
            } else {
            PG8_LDB(B0, 0, 0); PG8_SCHED; PG8_LDA(At, 0, 0); PG8_STAGE(PG8_SA(1, 1), a1 + hstep, voffA);
            PG8_WAIT_L(8); PG8_BAR; PG8_WAIT_L(0); PG8_MMA(0, 0, At, B0); PG8_BAR; PG8_SCHED;
            PG8_LDB(B1, 0, 1); PG8_STAGE(PG8_SB(0, 0), b2, voffB);
            PG8_BAR; PG8_WAIT_L(0); PG8_MMA(0, 1, At, B1); PG8_BAR;
            PG8_LDA(At, 0, 1); PG8_STAGE(PG8_SA(0, 0), a2, voffA);
            PG8_BAR; PG8_WAIT_L(0); PG8_MMA(1, 0, At, B0); PG8_BAR; PG8_SCHED;
            PG8_STAGE(PG8_SB(0, 1), b2 + hstep, voffB);
            PG8_WAIT_V(6); PG8_BAR; PG8_MMA(1, 1, At, B1); PG8_BAR;
            PG8_LDB(B0, 1, 0); PG8_SCHED; PG8_LDA(At, 1, 0); PG8_STAGE(PG8_SA(0, 1), a2 + hstep, voffA);
            PG8_WAIT_L(8); PG8_BAR; PG8_WAIT_L(0); PG8_MMA(0, 0, At, B0); PG8_BAR; PG8_SCHED;
            PG8_LDB(B1, 1, 1); PG8_STAGE(PG8_SB(1, 0), b3, voffB);
            PG8_BAR; PG8_WAIT_L(0); PG8_MMA(0, 1, At, B1); PG8_BAR;
            PG8_LDA(At, 1, 1); PG8_STAGE(PG8_SA(1, 0), a3, voffA);
            PG8_BAR; PG8_WAIT_L(0); PG8_MMA(1, 0, At, B0); PG8_BAR; PG8_SCHED;
            PG8_STAGE(PG8_SB(1, 1), b3 + hstep, voffB);
            PG8_WAIT_V(6); PG8_BAR; PG8_MMA(1, 1, At, B1); PG8_BAR;
            }
        }
        if constexpr (ALIGN_EPI) { if (wr == 0) PG8_BAR; }
        if constexpr (!Epi::AFTER_DRAIN) { E(acc, cur, wr, wc, fr, fq); S.done(cur); }
        if (!has_next) break;
#pragma unroll
        for (int a = 0; a < 2; ++a)
#pragma unroll
            for (int b = 0; b < 2; ++b)
#pragma unroll
                for (int m = 0; m < 4; ++m)
#pragma unroll
                    for (int n = 0; n < 2; ++n) acc[a][b][m][n] = (f32x4){0.f, 0.f, 0.f, 0.f};
        cur = nxt; cA = nA; cB = nB; ++ui;
        if constexpr (ALIGN_EPI) { if (wr == 1) PG8_BAR; }
    }
    PG8_WAIT_V(0);
    if constexpr (!ALIGN_EPI) { if (wr == 0) PG8_BAR; }
    PG8_BAR;
    if constexpr (Epi::AFTER_DRAIN) { E.fused(acc, cur, wr, wc, fr, fq, lds, wid, lane); S.done(cur); }
#undef PG8_SA
#undef PG8_SB
#undef PG8_STAGE
#undef PG8_LDA
#undef PG8_LDB
#undef PG8_MMA
#undef PG8_WAIT_V
#undef PG8_WAIT_L
#undef PG8_BAR
#undef PG8_SCHED
}
}

using pg8::bf16_t; using pg8::bf16x8; using pg8::f32x4; using pg8::u32x4; using pg8::u32x2; using pg8::f32x2; using pg8::cvtpk; using pg8::bf_lo; using pg8::bf_hi; using pg8::sigm;
typedef short s16x4 __attribute__((ext_vector_type(4)));
typedef float f32x16 __attribute__((ext_vector_type(16)));
typedef short v4i16_t __attribute__((ext_vector_type(4)));
constexpr int M = 16384, DM = 2048, SEQ = 4096;
constexpr float LOG2E = 1.4426950408889634f;
constexpr size_t MiB = 1u << 20;
constexpr size_t WS_SSQ0 = 0, WS_SSQ1 = 65536, WS_SSQ2 = 131072, WS_BTOT = 196608, WS_BAR = 524288, WS_CNT = 327680, WS_S5TAB = 1048576;
constexpr int LDS_MISC = 143360;
constexpr size_t WS_W0T = 2 * MiB, WS_WGT = 26 * MiB, WS_WO0T = 28 * MiB, WS_W1T = 36 * MiB, WS_WFT = 68 * MiB, WS_WO1T = 69 * MiB;
constexpr size_t WS_S5ST = 77 * MiB, WS_CUML = 85 * MiB, WS_XB = 86 * MiB;
constexpr size_t WS_P0 = 150 * MiB, WS_YG = 342 * MiB, WS_MIX = 374 * MiB, WS_P1 = 150 * MiB, WS_OG = 438 * MiB, WS_END = 502 * MiB;
constexpr int LDS_BYTES = 147456;
#ifndef DUP
#define DUP -1
#endif
#define REP(k) for (int rep_ = 0; rep_ < ((DUP == (k)) ? 2 : 1); ++rep_)

struct Args { const float* in[20]; float* out; unsigned char* ws; int ph_lo, ph_hi; };

DI s16x4 vtr(LAS const unsigned char* p) { return __builtin_bit_cast(s16x4, __builtin_amdgcn_ds_read_tr16_b64_v4i16((LAS v4i16_t*)p)); }
DI float wave_sum(float v) {
#pragma unroll
    for (int o = 1; o < 64; o <<= 1) v += __shfl_xor(v, o);
    return v;
}

DI float xhalf_max(float v) { float a = v, b = v; asm volatile("v_nop\n\tv_nop\n\tv_permlane32_swap_b32 %0, %1" : "+v"(a), "+v"(b)); return fmaxf(a, b); }
DI float xhalf_sum(float v) { float a = v, b = v; asm volatile("v_nop\n\tv_nop\n\tv_permlane32_swap_b32 %0, %1" : "+v"(a), "+v"(b)); return a + b; }

template <int D, int MODE>
DI void attn_unit(LAS unsigned char* lds, const bf16_t* QKV, const int LD, const int qoff, const int koff, const int voff,
                  const bf16_t* Z, const int LDZ, const int zoff, bf16_t* OUT, const int LDO, const int ooff,
                  const int b, const int h, const int qb, const float* aux0, const float* aux1, const bool keep_aux) {
    constexpr int ROWBK = D * 2 + 16, ROWBV = (D == 128) ? 320 : 192, KT = 64 * ROWBK, VT = 64 * ROWBV, VOFF = 2 * KT, AUX = 2 * KT + 2 * VT;
    constexpr int NCH = D / 64, CPR = D / 8, NKS = D / 16, NDT = D / 32;
    constexpr float THR = 64.f, NEG = -1e30f;
    int tid_ = threadIdx.x; asm volatile("" : "+v"(tid_));
    const int tid = tid_, lane = tid & 63, w = __builtin_amdgcn_readfirstlane(tid >> 6), r = lane & 31, hh = lane >> 5;
    const size_t rowbase = (size_t)b * SEQ; const int q0 = qb * 256;
    LAS float* auxf = (LAS float*)(lds + AUX);
    int kt0, kt1, ci = 0;
    if (MODE == 0) { const int c0 = qb * 4; kt0 = c0 - 8 < 0 ? 0 : c0 - 8; kt1 = c0 + 4; ci = c0 + (w >> 1); }
    else { kt0 = 0; kt1 = q0 / 64 + 4; }
    u32x4 kreg[NCH], vreg[NCH];
    const bf16_t* kvbase = QKV + rowbase * LD + h * D;
#define ATT_GLOAD(kt) do { _Pragma("unroll") for (int i_ = 0; i_ < NCH; ++i_) { const int c_ = tid + 512 * i_, row_ = c_ / CPR, c8_ = c_ % CPR; \
        const bf16_t* g_ = kvbase + (size_t)((kt) * 64 + row_) * LD + c8_ * 8; kreg[i_] = *(const u32x4*)(g_ + koff); vreg[i_] = *(const u32x4*)(g_ + voff); } } while (0)
#define ATT_LSTORE(buf) do { _Pragma("unroll") for (int i_ = 0; i_ < NCH; ++i_) { const int c_ = tid + 512 * i_, row_ = c_ / CPR, c8_ = c_ % CPR; \
        *(LAS u32x4*)(lds + (buf) * KT + row_ * ROWBK + c8_ * 16) = kreg[i_]; *(LAS u32x4*)(lds + VOFF + (buf) * VT + row_ * ROWBV + c8_ * 16) = vreg[i_]; } } while (0)
    bf16x8 qf[NKS];
    {
        const bf16_t* qp = QKV + (rowbase + q0 + w * 32 + r) * LD + qoff + h * D + 8 * hh;
#pragma unroll
        for (int ks = 0; ks < NKS; ++ks) qf[ks] = *(const bf16x8*)(qp + ks * 16);
    }
    ATT_GLOAD(kt0);
    if (!keep_aux) {
        if (MODE == 0) {
            for (int i = tid; i < 257; i += 512) auxf[i] = aux0[h * 257 + i] * LOG2E;
        } else {
            LAS float* pref = auxf + 4096;
            if (w == 0) {
                const float own = aux1[(b * 64 + lane) * 16 + h]; float v = own;
#pragma unroll
                for (int o = 1; o < 64; o <<= 1) { const float t = __shfl_up(v, o); if (lane >= o) v += t; }
                pref[lane] = v - own;
            }
            __syncthreads();
            const float* cl = aux0 + (size_t)(b * 16 + h) * SEQ;
            const int nk = q0 + 256;
#pragma unroll 1
            for (int kb = 0; kb < nk; kb += 2048) {
                float c[4];
#pragma unroll
                for (int j = 0; j < 4; ++j) { const int k = kb + tid + 512 * j; c[j] = (k < nk) ? cl[k] : 0.f; }
#pragma unroll
                for (int j = 0; j < 4; ++j) { const int k = kb + tid + 512 * j; if (k < nk) auxf[k] = (c[j] + pref[k >> 6]) * -LOG2E; }
            }
        }
    }
    __builtin_amdgcn_s_waitcnt(0x0F70);
    asm volatile("" ::: "memory");
    ATT_LSTORE(0);
    { const int t1_ = kt0 + 1 < kt1 ? kt0 + 1 : kt0; ATT_GLOAD(t1_); }
    f32x16 O[NDT];
#pragma unroll
    for (int dt = 0; dt < NDT; ++dt)
#pragma unroll
        for (int i = 0; i < 16; ++i) O[dt][i] = 0.f;
    float mref = NEG, lrun = 0.f;
    __syncthreads();
    const int q4 = (lane & 15) >> 2, p4 = lane & 3, blk = (lane >> 4) & 1;
    const int qw = q0 + 32 * w;
    for (int kt = kt0; kt < kt1; ++kt) {
        const int buf = (kt - kt0) & 1;
        ATT_LSTORE(buf ^ 1);
        { const int t2_ = kt + 2 < kt1 ? kt + 2 : kt1 - 1; ATT_GLOAD(t2_); }
        bool active; int jrel = 0;
        if (MODE == 0) { jrel = ci - kt; active = (jrel >= 0 && jrel <= 8); } else { active = (kt * 64 <= qw); }
        if (active) {
            const int k0 = kt * 64;
            LAS const unsigned char* kp = lds + buf * KT + r * ROWBK + hh * 16;
            bf16x8 kf[2][4];
#define ATT_KLOAD(g_, slot_) do { _Pragma("unroll") for (int q_ = 0; q_ < 2; ++q_) { kf[slot_][2 * q_] = *(LAS const bf16x8*)(kp + (2 * (g_) + q_) * 32); kf[slot_][2 * q_ + 1] = *(LAS const bf16x8*)(kp + 32 * ROWBK + (2 * (g_) + q_) * 32); } } while (0)
            ATT_KLOAD(0, 0);
            f32x16 S0, S1;
            if (MODE == 1) {
                LAS const float* ckp = auxf + k0 + 4 * hh;
#pragma unroll
                for (int g = 0; g < 4; ++g) {
                    const f32x4 c0 = *(LAS const f32x4*)(ckp + 8 * g), c1 = *(LAS const f32x4*)(ckp + 32 + 8 * g);
#pragma unroll
                    for (int e = 0; e < 4; ++e) { S0[4 * g + e] = c0[e]; S1[4 * g + e] = c1[e]; }
                }
            } else {
                if (jrel >= 3) { const float bfar = auxf[256];
#pragma unroll
                    for (int i = 0; i < 16; ++i) { S0[i] = bfar; S1[i] = bfar; }
                } else {
                    const int base = jrel * 64 + (w & 1) * 32 + r + 128 - 4 * hh;
#pragma unroll
                    for (int i = 0; i < 16; ++i) { const int cr = (i & 3) + 8 * (i >> 2); int i0 = base - cr, i1 = base - 32 - cr; i0 = i0 > 256 ? 256 : i0; i1 = i1 > 256 ? 256 : i1; S0[i] = auxf[i0]; S1[i] = auxf[i1]; }
                }
            }
            __builtin_amdgcn_sched_barrier(0);
#pragma unroll
            for (int g = 0; g < NKS / 2; ++g) {
                if (g + 1 < NKS / 2) ATT_KLOAD(g + 1, (g + 1) & 1);
#pragma unroll
                for (int q = 0; q < 2; ++q) {
                    S0 = __builtin_amdgcn_mfma_f32_32x32x16_bf16(kf[g & 1][2 * q], qf[2 * g + q], S0, 0, 0, 0);
                    S1 = __builtin_amdgcn_mfma_f32_32x32x16_bf16(kf[g & 1][2 * q + 1], qf[2 * g + q], S1, 0, 0, 0);
                    if (DUP == 201 && MODE == 1) {
                        const bf16x8 n0 = kf[g & 1][2 * q] ^ (short)0x8000, n1 = kf[g & 1][2 * q + 1] ^ (short)0x8000;
                        S0 = __builtin_amdgcn_mfma_f32_32x32x16_bf16(n0, qf[2 * g + q], S0, 0, 0, 0); S1 = __builtin_amdgcn_mfma_f32_32x32x16_bf16(n1, qf[2 * g + q], S1, 0, 0, 0);
                        S0 = __builtin_amdgcn_mfma_f32_32x32x16_bf16(kf[g & 1][2 * q], qf[2 * g + q], S0, 0, 0, 0); S1 = __builtin_amdgcn_mfma_f32_32x32x16_bf16(kf[g & 1][2 * q + 1], qf[2 * g + q], S1, 0, 0, 0);
                    }
                }
                __builtin_amdgcn_sched_barrier(0);
            }
#undef ATT_KLOAD
            if (MODE == 1) {
                if (k0 + 63 > qw) {
                    const int lim = qw + r - k0;
#pragma unroll
                    for (int i = 0; i < 16; ++i) { const int kl = (i & 3) + 8 * (i >> 2) + 4 * hh; if (kl > lim) S0[i] = NEG; if (kl + 32 > lim) S1[i] = NEG; }
                }
            }
            float mx;
            asm volatile("s_nop 15\n\ts_nop 3\n\tv_max3_f32 %0, %1, %2, %3" : "=v"(mx) : "v"(S0[0]), "v"(S1[0]), "v"(S0[1]));
#pragma unroll
            for (int i = 1; i < 15; ++i) asm volatile("v_max3_f32 %0, %0, %1, %2" : "+v"(mx) : "v"(S1[i]), "v"(S0[i + 1]));
            asm volatile("v_max_f32 %0, %0, %1" : "+v"(mx) : "v"(S1[15]));
            mx = xhalf_max(mx);
            if (__any(mx > mref + THR)) {
                const float mnew = fmaxf(mref, mx);
                const float alpha = __builtin_amdgcn_exp2f(mref - mnew);
                mref = mnew; lrun *= alpha;
#pragma unroll
                for (int dt = 0; dt < NDT; ++dt)
#pragma unroll
                    for (int i = 0; i < 16; ++i) O[dt][i] *= alpha;
            }
            float ps = 0.f;
#pragma unroll
            for (int i = 0; i < 16; ++i) { S0[i] = __builtin_amdgcn_exp2f(S0[i] - mref); S1[i] = __builtin_amdgcn_exp2f(S1[i] - mref); ps += S0[i] + S1[i]; }
            lrun += ps;
            bf16x8 pf[4];
#pragma unroll
            for (int s = 0; s < 2; ++s) {
                u32x4 pk; pk.x = cvtpk(S0[8 * s], S0[8 * s + 1]); pk.y = cvtpk(S0[8 * s + 2], S0[8 * s + 3]); pk.z = cvtpk(S0[8 * s + 4], S0[8 * s + 5]); pk.w = cvtpk(S0[8 * s + 6], S0[8 * s + 7]); pf[s] = __builtin_bit_cast(bf16x8, pk);
                u32x4 pq; pq.x = cvtpk(S1[8 * s], S1[8 * s + 1]); pq.y = cvtpk(S1[8 * s + 2], S1[8 * s + 3]); pq.z = cvtpk(S1[8 * s + 4], S1[8 * s + 5]); pq.w = cvtpk(S1[8 * s + 6], S1[8 * s + 7]); pf[2 + s] = __builtin_bit_cast(bf16x8, pq);
            }
            __builtin_amdgcn_sched_barrier(0);
            LAS const unsigned char* vp = lds + VOFF + buf * VT + (4 * hh + q4) * ROWBV + blk * 32 + p4 * 8;
            s16x4 vlo[2][4], vhi[2][4];
#define ATT_VLOAD(dt_, slot_) do { _Pragma("unroll") for (int kk_ = 0; kk_ < 4; ++kk_) { vlo[slot_][kk_] = vtr(vp + (16 * kk_) * ROWBV + (dt_) * 64); vhi[slot_][kk_] = vtr(vp + (16 * kk_ + 8) * ROWBV + (dt_) * 64); } } while (0)
            ATT_VLOAD(0, 0);
            __builtin_amdgcn_sched_barrier(0);
#pragma unroll
            for (int dt = 0; dt < NDT; ++dt) {
                if (dt + 1 < NDT) ATT_VLOAD(dt + 1, (dt + 1) & 1);
#pragma unroll
                for (int kk = 0; kk < 4; ++kk) {
                    const bf16x8 vf = __builtin_shufflevector(vlo[dt & 1][kk], vhi[dt & 1][kk], 0, 1, 2, 3, 4, 5, 6, 7);
                    O[dt] = __builtin_amdgcn_mfma_f32_32x32x16_bf16(vf, pf[kk], O[dt], 0, 0, 0);
                }
                __builtin_amdgcn_sched_barrier(0);
            }
#undef ATT_VLOAD
        }
        asm volatile("s_waitcnt lgkmcnt(0)\n\ts_barrier" ::: "memory");
    }
#undef ATT_GLOAD
#undef ATT_LSTORE
    const float inv = 1.f / xhalf_sum(lrun);
    int lane2 = lane; asm volatile("" : "+v"(lane2));
    LAS unsigned char* st = lds + w * 32 * ROWBK;
    constexpr int NIT = 32 * CPR / 64;
    u32x4 zq[NIT];
#pragma unroll
    for (int it = 0; it < NIT; ++it) { const int idx = it * 64 + lane2, row = idx / CPR, c8 = idx % CPR; zq[it] = *(const u32x4*)(Z + (rowbase + q0 + w * 32 + row) * LDZ + zoff + h * D + c8 * 8); }
#pragma unroll
    for (int dt = 0; dt < NDT; ++dt)
#pragma unroll
        for (int g = 0; g < 4; ++g) {
            u32x2 pk; pk.x = cvtpk(O[dt][4 * g] * inv, O[dt][4 * g + 1] * inv); pk.y = cvtpk(O[dt][4 * g + 2] * inv, O[dt][4 * g + 3] * inv);
            *(LAS u32x2*)(st + (lane2 & 31) * ROWBK + (dt * 32 + 8 * g + 4 * (lane2 >> 5)) * 2) = pk;
        }
    asm volatile("s_waitcnt lgkmcnt(0)" ::: "memory");
#pragma unroll
    for (int it = 0; it < NIT; ++it) {
        const int idx = it * 64 + lane2, row = idx / CPR, c8 = idx % CPR;
        const u32x4 o8 = *(LAS const u32x4*)(st + row * ROWBK + c8 * 16);
        const size_t grow = rowbase + q0 + w * 32 + row;
        const u32x4 z8 = zq[it];
        u32x4 res;
#pragma unroll
        for (int e = 0; e < 4; ++e) {
            const float o0 = bf_lo(o8[e]), o1 = bf_hi(o8[e]), z0 = bf_lo(z8[e]), z1 = bf_hi(z8[e]);
            res[e] = cvtpk(o0 * z0 * sigm(z0), o1 * z1 * sigm(z1));
        }
        *(u32x4*)(OUT + grow * LDO + ooff + h * D + c8 * 8) = res;
    }
    __syncthreads();
}

DI double exp_d(double z) {
    const double n = rint(z * 1.4426950408889634074);
    const double rr = (z - n * 6.93147180369123816490e-01) - n * 1.90821492927058770002e-10;
    double p = 1.0 / 39916800.0;
    p = p * rr + 1.0 / 3628800.0; p = p * rr + 1.0 / 362880.0; p = p * rr + 1.0 / 40320.0; p = p * rr + 1.0 / 5040.0; p = p * rr + 1.0 / 720.0;
    p = p * rr + 1.0 / 120.0; p = p * rr + 1.0 / 24.0; p = p * rr + 1.0 / 6.0; p = p * rr + 0.5; p = p * rr + 1.0; p = p * rr + 1.0;
    const long long bits = (long long)(1023 + (int)n) << 52;
    return p * __builtin_bit_cast(double, bits);
}
DI void sincos_d(double x, double& sn, double& cs) {
    const double k = rint(x * 0.63661977236758134308);
    const double rr = (x - k * 1.57079632673412561417e+00) - k * 6.07710050650619224932e-11;
    const double r2 = rr * rr;
    double s = 1.0 / 6227020800.0; s = s * r2 - 1.0 / 39916800.0; s = s * r2 + 1.0 / 362880.0; s = s * r2 - 1.0 / 5040.0; s = s * r2 + 1.0 / 120.0; s = s * r2 - 1.0 / 6.0; s = rr + rr * r2 * s;
    double c = -1.0 / 87178291200.0; c = c * r2 + 1.0 / 479001600.0; c = c * r2 - 1.0 / 3628800.0; c = c * r2 + 1.0 / 40320.0; c = c * r2 - 1.0 / 720.0; c = c * r2 + 1.0 / 24.0; c = c * r2 - 0.5; c = 1.0 + c * r2;
    const int q = ((int)k) & 3;
    sn = (q == 0) ? s : (q == 1) ? c : (q == 2) ? -s : -c;
    cs = (q == 0) ? c : (q == 1) ? -s : (q == 2) ? -c : s;
}

template <bool P2>
DI void s5_pass(LAS unsigned char* lds, const Args& a) {
    const int tid = threadIdx.x, lane = tid & 63, w = __builtin_amdgcn_readfirstlane(tid >> 6), r = lane & 31, hh = lane >> 5;
    LAS unsigned char* stl = lds + w * 9216;
    const bf16_t* P0 = (const bf16_t*)(a.ws + WS_P0);
    f32x2* S5ST = (f32x2*)(a.ws + WS_S5ST);
    bf16_t* YG = (bf16_t*)(a.ws + WS_YG);
    const int hhrow = (r >> 2) & 1, irow = (r & 3) + 4 * (r >> 3);
    for (int task = blockIdx.x; task < 1024; task += gridDim.x) {
        const int g8 = task & 7, c = (task >> 3) & 63, bp = task >> 9;
        const int g = g8 * 8 + w;
        const int b = bp * 2 + hh;
        float are[2], aim[2], xr[2], xi[2], a64r[2], a64i[2];
        bf16x8 bfrag[2][2];
#pragma unroll
        for (int ps = 0; ps < 2; ++ps) {
            const int p = r + 32 * ps;
            const f32x4* tp = (const f32x4*)(a.ws + WS_S5TAB) + (size_t)(g * 64 + p) * 2;
            const f32x4 t0 = tp[0], t1 = tp[1];
            are[ps] = t0[0]; aim[ps] = t0[1];
            const float cre = t0[2], cim = t0[3];
            const f32x4* br = (const f32x4*)(a.in[7] + (size_t)(g * 64 + p) * 16 + 8 * hh); const f32x4* bi = (const f32x4*)(a.in[8] + (size_t)(g * 64 + p) * 16 + 8 * hh);
            const f32x4 x0 = br[0], x1 = br[1], y0 = bi[0], y1 = bi[1];
            u32x4 kr, ki;
            kr.x = cvtpk(cre * x0[0] - cim * y0[0], cre * x0[1] - cim * y0[1]); kr.y = cvtpk(cre * x0[2] - cim * y0[2], cre * x0[3] - cim * y0[3]);
            kr.z = cvtpk(cre * x1[0] - cim * y1[0], cre * x1[1] - cim * y1[1]); kr.w = cvtpk(cre * x1[2] - cim * y1[2], cre * x1[3] - cim * y1[3]);
            ki.x = cvtpk(cre * y0[0] + cim * x0[0], cre * y0[1] + cim * x0[1]); ki.y = cvtpk(cre * y0[2] + cim * x0[2], cre * y0[3] + cim * x0[3]);
            ki.z = cvtpk(cre * y1[0] + cim * x1[0], cre * y1[1] + cim * x1[1]); ki.w = cvtpk(cre * y1[2] + cim * x1[2], cre * y1[3] + cim * x1[3]);
            bfrag[0][ps] = __builtin_bit_cast(bf16x8, kr); bfrag[1][ps] = __builtin_bit_cast(bf16x8, ki);
            xr[ps] = 0.f; xi[ps] = 0.f;
            a64r[ps] = t1[0]; a64i[ps] = t1[1];
        }
        bf16x8 cf[4]; f32x4 dsk = {0.f, 0.f, 0.f, 0.f};
        const int tl = lane & 15, kq = lane >> 4;
        if (P2) {
            const f32x2* se = S5ST + ((size_t)(b * 64) * 64 + g) * 64 + r;
#pragma unroll 4
            for (int cc = 0; cc < c; ++cc) {
                const f32x2 e0 = se[(size_t)cc * 4096], e1 = se[(size_t)cc * 4096 + 32];
                const float n0r = a64r[0] * xr[0] - a64i[0] * xi[0] + e0.x, n0i = a64r[0] * xi[0] + a64i[0] * xr[0] + e0.y;
                const float n1r = a64r[1] * xr[1] - a64i[1] * xi[1] + e1.x, n1i = a64r[1] * xi[1] + a64i[1] * xr[1] + e1.y;
                xr[0] = n0r; xi[0] = n0i; xr[1] = n1r; xi[1] = n1i;
            }
#pragma unroll
            for (int kk = 0; kk < 4; ++kk) {
                const size_t off = (size_t)(g * 16 + tl) * 64 + kk * 16 + 4 * kq;
                const f32x4 re = *(const f32x4*)(a.in[9] + off), im = *(const f32x4*)(a.in[10] + off);
                u32x4 pk; pk.x = cvtpk(re[0], -im[0]); pk.y = cvtpk(re[1], -im[1]); pk.z = cvtpk(re[2], -im[2]); pk.w = cvtpk(re[3], -im[3]);
                cf[kk] = __builtin_bit_cast(bf16x8, pk);
            }
            dsk = *(const f32x4*)(a.in[11] + g * 16 + 4 * kq);
        }
        const bf16_t* ubase = P0 + ((size_t)(bp * 2 + hhrow) * SEQ + c * 64 + irow) * 6144 + 3072 + g * 16 + 8 * hh;
        bf16x8 af[4];
#pragma unroll
        for (int rbk = 0; rbk < 4; ++rbk) af[rbk] = *(const bf16x8*)(ubase + (size_t)rbk * 16 * 6144);
        u32x2 usk[4][2];
        if (P2) {
#pragma unroll
            for (int rbk = 0; rbk < 4; ++rbk)
#pragma unroll
                for (int h2 = 0; h2 < 2; ++h2) usk[rbk][h2] = *(const u32x2*)(P0 + ((size_t)(bp * 2 + h2) * SEQ + c * 64 + rbk * 16 + tl) * 6144 + 3072 + g * 16 + 4 * kq);
        }
#pragma unroll
        for (int rbk = 0; rbk < 4; ++rbk) {
            f32x16 Dv[2][2];
#pragma unroll
            for (int part = 0; part < 2; ++part)
#pragma unroll
                for (int ps = 0; ps < 2; ++ps) {
                    f32x16 z;
#pragma unroll
                    for (int i = 0; i < 16; ++i) z[i] = 0.f;
                    Dv[part][ps] = __builtin_amdgcn_mfma_f32_32x32x16_bf16(af[rbk], bfrag[part][ps], z, 0, 0, 0);
                }
#pragma unroll
            for (int i = 0; i < 16; ++i) {
#pragma unroll
                for (int ps = 0; ps < 2; ++ps) {
                    const float nxr = are[ps] * xr[ps] - aim[ps] * xi[ps] + Dv[0][ps][i], nxi = are[ps] * xi[ps] + aim[ps] * xr[ps] + Dv[1][ps][i];
                    xr[ps] = nxr; xi[ps] = nxi;
                    if (P2) *(LAS unsigned*)(stl + hh * 4352 + i * 272 + (r + 32 * ps) * 4) = cvtpk(nxr, nxi);
                }
            }
            if (P2) {
                asm volatile("s_waitcnt lgkmcnt(0)" ::: "memory");
#pragma unroll
                for (int h2 = 0; h2 < 2; ++h2) {
                    f32x4 acc = {0.f, 0.f, 0.f, 0.f};
#pragma unroll
                    for (int kk = 0; kk < 4; ++kk) { const bf16x8 xb = *(LAS const bf16x8*)(stl + h2 * 4352 + tl * 272 + kk * 64 + kq * 16); acc = __builtin_amdgcn_mfma_f32_16x16x32_bf16(cf[kk], xb, acc, 0, 0, 0); }
                    const size_t row = (size_t)(bp * 2 + h2) * SEQ + c * 64 + rbk * 16 + tl;
                    const u32x2 u4 = usk[rbk][h2];
                    float y[4]; y[0] = acc[0] + dsk[0] * bf_lo(u4.x); y[1] = acc[1] + dsk[1] * bf_hi(u4.x); y[2] = acc[2] + dsk[2] * bf_lo(u4.y); y[3] = acc[3] + dsk[3] * bf_hi(u4.y);
#pragma unroll
                    for (int e = 0; e < 4; ++e) { const float v = y[e]; const float z2 = 1.5957691216057308f * (v + 0.044715f * v * v * v); y[e] = v * sigm(z2); }
                    u32x2 o; o.x = cvtpk(y[0], y[1]); o.y = cvtpk(y[2], y[3]);
                    *(u32x2*)(YG + row * 1024 + g * 16 + 4 * kq) = o;
                }
                asm volatile("s_waitcnt lgkmcnt(0)" ::: "memory");
            }
        }
        if (!P2) {
#pragma unroll
            for (int ps = 0; ps < 2; ++ps) { f32x2 e; e.x = xr[ps]; e.y = xi[ps]; S5ST[((size_t)(b * 64 + c) * 64 + g) * 64 + r + 32 * ps] = e; }
        }
    }
}

DI void transpose_item(const float* W, int ld, int K, int nvalid, const float* gk, bf16_t* WT, int kb, int n0, int lane) {
    const int n = n0 + lane, k0 = kb * 32;
    if (n < nvalid) {
        const float* wp = W + (size_t)k0 * ld + n;
        float v[32];
#pragma unroll
        for (int e = 0; e < 32; ++e) v[e] = wp[(size_t)e * ld];
        if (gk) {
#pragma unroll
            for (int e = 0; e < 32; ++e) v[e] *= gk[k0 + e];
        }
        u32x4* dst = (u32x4*)(WT + (size_t)n * K + k0);
#pragma unroll
        for (int q = 0; q < 4; ++q) { u32x4 o; o.x = cvtpk(v[8 * q], v[8 * q + 1]); o.y = cvtpk(v[8 * q + 2], v[8 * q + 3]); o.z = cvtpk(v[8 * q + 4], v[8 * q + 5]); o.w = cvtpk(v[8 * q + 6], v[8 * q + 7]); dst[q] = o; }
    }
}

DI void prologue(LAS unsigned char* lds, const Args& a) {
    const int tid = threadIdx.x, lane = tid & 63, w = __builtin_amdgcn_readfirstlane(tid >> 6);
    const int gw = blockIdx.x * 8 + w, NGW = gridDim.x * 8;
    unsigned char* ws = a.ws;
    constexpr int I0 = 96 * 64, I1 = 16 * 32, I2 = 32 * 64, I3 = 128 * 64, I4 = 64, I5 = 32 * 64, NIT = I0 + I1 + I2 + I3 + I4 + I5;
#pragma unroll 1
    for (int it = gw; it < NIT; it += NGW) {
        int q = it;
        if (q < I0) { transpose_item(a.in[2], 6144, 2048, 6144, a.in[1], (bf16_t*)(ws + WS_W0T), q & 63, (q >> 6) * 64, lane); continue; } q -= I0;
        if (q < I1) { transpose_item(a.in[12], 1024, 1024, 1024, nullptr, (bf16_t*)(ws + WS_WGT), q & 31, (q >> 5) * 64, lane); continue; } q -= I1;
        if (q < I2) { transpose_item(a.in[14], 2048, 2048, 2048, nullptr, (bf16_t*)(ws + WS_WO0T), q & 63, (q >> 6) * 64, lane); continue; } q -= I2;
        if (q < I3) { transpose_item(a.in[16], 8208, 2048, 8192, a.in[15], (bf16_t*)(ws + WS_W1T), q & 63, (q >> 6) * 64, lane); continue; } q -= I3;
        if (q < I4) { transpose_item(a.in[16] + 8192, 8208, 2048, 16, a.in[15], (bf16_t*)(ws + WS_WFT), q, 0, lane); continue; } q -= I4;
        transpose_item(a.in[18], 2048, 2048, 2048, nullptr, (bf16_t*)(ws + WS_WO1T), q & 63, (q >> 6) * 64, lane);
    }
    float* ssq0 = (float*)(ws + WS_SSQ0); bf16_t* XB = (bf16_t*)(ws + WS_XB);
    for (int m = gw; m < M; m += NGW) {
        const f32x4* xr = (const f32x4*)(a.in[0] + (size_t)m * DM) + lane;
        f32x4 v[8]; float s = 0.f;
#pragma unroll
        for (int j = 0; j < 8; ++j) { v[j] = xr[64 * j]; s += (v[j][0] * v[j][0] + v[j][1] * v[j][1]) + (v[j][2] * v[j][2] + v[j][3] * v[j][3]); }
        s = wave_sum(s);
        u32x2* o8 = (u32x2*)(XB + (size_t)m * DM) + lane;
#pragma unroll
        for (int j = 0; j < 8; ++j) { u32x2 o; o.x = cvtpk(v[j][0], v[j][1]); o.y = cvtpk(v[j][2], v[j][3]); o8[64 * j] = o; }
        if (lane == 0) ssq0[m] = s;
    }
    for (int i = blockIdx.x * 512 + tid; i < 4096; i += gridDim.x * 512) {
        const int g = i >> 6;
        const double lr = (double)a.in[4][i], li = (double)a.in[5][i];
        const double dt = exp_d((double)a.in[6][g]);
        const double mag = exp_d(lr * dt);
        double sn, cs; sincos_d(li * dt, sn, cs);
        const double dare = mag * cs, daim = mag * sn;
        const double nr = dare - 1.0, ni = daim, den = lr * lr + li * li;
        double pr = dare, pi = daim;
#pragma unroll
        for (int q = 0; q < 6; ++q) { const double tr = pr * pr - pi * pi, ti = 2.0 * pr * pi; pr = tr; pi = ti; }
        f32x4 t0, t1; t0[0] = (float)dare; t0[1] = (float)daim; t0[2] = (float)((nr * lr + ni * li) / den); t0[3] = (float)((ni * lr - nr * li) / den);
        t1[0] = (float)pr; t1[1] = (float)pi; t1[2] = 0.f; t1[3] = 0.f;
        f32x4* tp = (f32x4*)(ws + WS_S5TAB) + (size_t)i * 2; tp[0] = t0; tp[1] = t1;
    }
    float* ssq1 = (float*)(ws + WS_SSQ1); float* ssq2 = (float*)(ws + WS_SSQ2);
    for (int i = blockIdx.x * 512 + tid; i < M; i += gridDim.x * 512) { ssq1[i] = 0.f; ssq2[i] = 0.f; }
    if (blockIdx.x == 0) for (int i = tid; i < 64 * 64; i += 512) ((unsigned*)(ws + WS_CNT))[i] = 0u;
}

DI void flogit_phase(LAS unsigned char* lds, const Args& a) {
    const int tid = threadIdx.x, lane = tid & 63, w = __builtin_amdgcn_readfirstlane(tid >> 6);
    const bf16_t* X1B = (const bf16_t*)(a.ws + WS_XB); const bf16_t* WFT = (const bf16_t*)(a.ws + WS_WFT);
    const float* ssq1 = (const float*)(a.ws + WS_SSQ1);
    float* cuml = (float*)(a.ws + WS_CUML); float* btot = (float*)(a.ws + WS_BTOT);
    LAS float* part = (LAS float*)lds;
    LAS float* lf = part + 1024;
    const int rg = w & 3, kh = w >> 2, l15 = lane & 15, kq = lane >> 4;
    for (int rb = blockIdx.x; rb < M / 64; rb += gridDim.x) {
        const size_t R0 = (size_t)rb * 64 + rg * 16;
        const bf16_t* ap = X1B + (R0 + l15) * DM + kh * 1024 + 8 * kq;
        const bf16_t* bp = WFT + (size_t)l15 * DM + kh * 1024 + 8 * kq;
        f32x4 acc = {0.f, 0.f, 0.f, 0.f};
#pragma unroll 8
        for (int kk = 0; kk < 32; ++kk) { const bf16x8 af = *(const bf16x8*)(ap + kk * 32), bf = *(const bf16x8*)(bp + kk * 32); acc = __builtin_amdgcn_mfma_f32_16x16x32_bf16(af, bf, acc, 0, 0, 0); }
        if (kh == 1) {
#pragma unroll
            for (int e = 0; e < 4; ++e) part[rg * 256 + (4 * kq + e) * 16 + l15] = acc[e];
        }
        __syncthreads();
        if (kh == 0) {
            const float bfg = a.in[17][l15];
#pragma unroll
            for (int e = 0; e < 4; ++e) {
                const int tok = 4 * kq + e; const size_t row = R0 + tok;
                const float rs = 1.f / sqrtf(ssq1[row] * (1.f / 2048.f) + 1e-6f);
                const float f = (acc[e] + part[rg * 256 + tok * 16 + l15]) * rs + bfg;
                const float ls = fminf(f, 0.f) - log1pf(__expf(-fabsf(f)));
                lf[(rg * 16 + tok) * 16 + l15] = ls;
            }
        }
        __syncthreads();
        if (tid < 16) {
            const int bb = rb >> 6, t0 = (rb & 63) * 64; float cum = 0.f;
            float* cp = cuml + (size_t)(bb * 16 + tid) * SEQ + t0;
            for (int i = 0; i < 64; ++i) { cum += lf[i * 16 + tid]; cp[i] = cum; }
            btot[rb * 16 + tid] = cum;
        }
        __syncthreads();
    }
}

DI void final_norm(const Args& a) {
    const int tid = threadIdx.x, lane = tid & 63, w = tid >> 6;
    const int gw = blockIdx.x * 8 + w, NGW = gridDim.x * 8;
    const float* ssq2 = (const float*)(a.ws + WS_SSQ2);
    const f32x4* gp = (const f32x4*)a.in[19] + lane;
    for (int m = gw; m < M; m += NGW) {
        const float rs = 1.f / sqrtf(ssq2[m] * (1.f / 2048.f) + 1e-6f);
        f32x4* xr = (f32x4*)(a.out + (size_t)m * DM) + lane;
#pragma unroll
        for (int j = 0; j < 8; ++j) { f32x4 v = xr[64 * j]; const f32x4 g = gp[64 * j]; v = v * rs * g; xr[64 * j] = v; }
    }
}

#define XB_TMO      128
#define XB_XCNT(j)  (256  + 64 * (j))
#define XB_XSUB(j)  (1280 + 64 * (j))
#define XB_XGEN(j)  (2304 + 64 * (j))
#define XB_TOP      3328
#define XB_TOPGEN   3392
#define XCD_BAR_WORDS 3456
#define XB_SPIN_CAP (1u << 18)

__device__ __forceinline__ unsigned xb_ld(unsigned* p)              { return __hip_atomic_load(p, __ATOMIC_RELAXED, __HIP_MEMORY_SCOPE_AGENT); }
__device__ __forceinline__ unsigned xb_add(unsigned* p, unsigned v) { return __hip_atomic_fetch_add(p, v, __ATOMIC_RELAXED, __HIP_MEMORY_SCOPE_AGENT); }
__device__ __forceinline__ unsigned xb_xcc_id() { return (unsigned)__builtin_amdgcn_s_getreg((3 << 11) | 20) & 0xFu; }
#define XB_SPIN(cond, bar) do { unsigned _sp = 0; while (cond) { __builtin_amdgcn_s_sleep(1); \
    if ((++_sp & 255u) == 0u) { if (xb_ld(&(bar)[XB_TMO])) break; if (_sp > XB_SPIN_CAP) { atomicAdd(&(bar)[XB_TMO], 1u); break; } } } } while (0)

struct XcdBarrier {
    unsigned* bar; unsigned x;
    volatile LAS unsigned* st;
};

__device__ __forceinline__ XcdBarrier xcd_barrier_post(unsigned* bar, volatile LAS unsigned* st) {
    XcdBarrier b; b.bar = bar; b.x = xb_xcc_id(); b.st = st;
    if (threadIdx.x == 0) (void)xb_add(&bar[XB_XCNT(b.x)], 1u);
    return b;
}
__device__ __forceinline__ void xcd_barrier_complete(unsigned* bar, unsigned x, unsigned& nloc, unsigned& nx) {
    const unsigned G = gridDim.x * gridDim.y * gridDim.z;
    unsigned sum, cnt, mine, sp = 0u;
    for (;;) {
        sum = 0u; cnt = 0u; mine = 0u;
#pragma unroll
        for (unsigned j = 0; j < 16; ++j) { const unsigned c = xb_ld(&bar[XB_XCNT(j)]); sum += c; cnt += (c > 0u) ? 1u : 0u; mine = (j == x) ? c : mine; }
        if (sum == G) break;
        __builtin_amdgcn_s_sleep(1);
        if ((++sp & 255u) == 0u) { if (xb_ld(&bar[XB_TMO])) break; if (sp > XB_SPIN_CAP) { atomicAdd(&bar[XB_TMO], 1u); break; } }
    }
    nloc = mine > 0u ? mine : 1u; nx = cnt > 0u ? cnt : 1u;
}

__device__ __forceinline__ void xcd_barrier(const XcdBarrier& b) {
    asm volatile("s_waitcnt vmcnt(0)" ::: "memory");
    __syncthreads();
    if (threadIdx.x == 0) {
        unsigned* bar = b.bar;
        __builtin_amdgcn_s_waitcnt(0);
        unsigned nloc = b.st[0], nx = b.st[1];
        if (nloc == 0u) { xcd_barrier_complete(bar, b.x, nloc, nx); b.st[0] = nloc; b.st[1] = nx; }
        const unsigned old = xb_add(&bar[XB_XSUB(b.x)], 1u);
        const unsigned gen = old / nloc;
        if (old + 1u == (gen + 1u) * nloc) {
            __builtin_amdgcn_fence(__ATOMIC_RELEASE, "agent");
            asm volatile("s_waitcnt vmcnt(0)" ::: "memory");
            const unsigned og = xb_add(&bar[XB_TOP], 1u);
            const unsigned tg = og / nx;
            if (og + 1u == (tg + 1u) * nx) xb_add(&bar[XB_TOPGEN], 1u);
            else XB_SPIN(xb_ld(&bar[XB_TOPGEN]) == tg, bar);
            __builtin_amdgcn_fence(__ATOMIC_ACQUIRE, "agent");
            xb_add(&bar[XB_XGEN(b.x)], 1u);
            asm volatile("s_waitcnt vmcnt(0)" ::: "memory");
        } else {
            XB_SPIN(xb_ld(&bar[XB_XGEN(b.x)]) == gen, bar);
            __builtin_amdgcn_fence(__ATOMIC_ACQUIRE, "agent");
            asm volatile("s_waitcnt vmcnt(0)" ::: "memory");
        }
    }
    __syncthreads();
}

__global__ void __launch_bounds__(512, 2) mega(Args a) {
    extern __shared__ __attribute__((aligned(16))) unsigned char lds_raw[];
    LAS unsigned char* lds = (LAS unsigned char*)lds_raw;
    cg::grid_group grid = cg::this_grid();
    if (threadIdx.x < 4) ((LAS unsigned*)(lds + LDS_MISC))[threadIdx.x] = 0u;
    __syncthreads();
    unsigned* barw = (unsigned*)(a.ws + WS_BAR);
    XcdBarrier xbar; xbar.bar = barw; xbar.x = 0; xbar.st = (volatile LAS unsigned*)(lds + LDS_MISC);
    const int lo = a.ph_lo, hi = a.ph_hi;
    const int G = gridDim.x, bx = blockIdx.x;
    const int vcu = (G % 8 == 0) ? (bx % 8) * (G / 8) + bx / 8 : bx;
    unsigned char* ws = a.ws;
#define IN(k) (lo <= (k) && (k) < hi)
#define SEAM(k) do { if (IN(k) && IN((k) + 1)) xcd_barrier(xbar); } while (0)
    if (lo < 0) grid.sync();
    xbar = xcd_barrier_post(barw, (volatile LAS unsigned*)(lds + LDS_MISC));
    if (IN(0)) { REP(0) prologue(lds, a); }
    SEAM(0);
    if (IN(1)) {
        pg8::Gemm g{(const bf16_t*)(ws + WS_XB), (const bf16_t*)(ws + WS_W0T), M, 6144, 2048}; pg8::StaticOrder S; S.init(M, 6144, G, bx);
        pg8::EpiProj E{(bf16_t*)(ws + WS_P0), 6144, (const float*)(ws + WS_SSQ0), 1024, 0.125f * LOG2E};
        REP(1) pg8::gemm_phase<pg8::EpiProj, pg8::StaticOrder, true, true>(lds, g, S, E);
    }
    SEAM(1);
    if (IN(2)) {
        const bf16_t* P0 = (const bf16_t*)(ws + WS_P0);
        int prev_h = -1;
        REP(20) for (int u = vcu; u < 1024; u += G) {
            const int bh = u >> 4, qb = u & 15;
            attn_unit<64, 0>(lds, P0, 6144, 0, 1024, 2048, P0, 6144, 4096, (bf16_t*)(ws + WS_MIX), 2048, 0, bh >> 4, bh & 15, qb, a.in[3], nullptr, prev_h == (bh & 15));
            prev_h = bh & 15;
        }
        REP(21) s5_pass<false>(lds, a);
    }
    SEAM(2);
    if (IN(3)) { REP(3) s5_pass<true>(lds, a); }
    SEAM(3);
    if (IN(4)) {
        pg8::Gemm g{(const bf16_t*)(ws + WS_YG), (const bf16_t*)(ws + WS_WGT), M, 1024, 1024}; pg8::StaticOrder S; S.init(M, 1024, G, bx);
        pg8::EpiGlu E{(const bf16_t*)(ws + WS_YG), 1024, (const bf16_t*)(ws + WS_P0) + 5120, 6144, a.in[13], (bf16_t*)(ws + WS_MIX) + 1024, 2048};
        REP(4) pg8::gemm_phase<pg8::EpiGlu, pg8::StaticOrder, true, true>(lds, g, S, E);
    }
    SEAM(4);
    if (IN(5)) {
        pg8::Gemm g{(const bf16_t*)(ws + WS_MIX), (const bf16_t*)(ws + WS_WO0T), M, 2048, 2048}; pg8::StaticOrder S; S.init(M, 2048, G, bx);
        pg8::EpiRes E{nullptr, (const bf16_t*)(ws + WS_XB), nullptr, (bf16_t*)(ws + WS_XB), (float*)(ws + WS_SSQ1)};
        if (DUP == 5) { pg8::EpiRes E2{a.in[0], nullptr, nullptr, (bf16_t*)(ws + WS_XB), (float*)(ws + 262144)}; pg8::gemm_phase<pg8::EpiRes, pg8::StaticOrder, true, true>(lds, g, S, E2); }
        pg8::gemm_phase<pg8::EpiRes, pg8::StaticOrder, true, true>(lds, g, S, E);
    }
    SEAM(5);
    if (IN(6)) {
        REP(60) flogit_phase(lds, a);
        pg8::Gemm g{(const bf16_t*)(ws + WS_XB), (const bf16_t*)(ws + WS_W1T), M, 8192, 2048}; pg8::StaticOrder S; S.init(M, 8192, G, bx);
        pg8::EpiProj E{(bf16_t*)(ws + WS_P1), 8192, (const float*)(ws + WS_SSQ1), 2048, 0.08838834764831845f * LOG2E};
        REP(6) pg8::gemm_phase<pg8::EpiProj, pg8::StaticOrder, true, true>(lds, g, S, E);
    }
    SEAM(6);
    if (IN(7)) {
        const bf16_t* P1 = (const bf16_t*)(ws + WS_P1);
        REP(7) for (int pi = vcu; pi < 512; pi += G) {
            const int bh = pi >> 3, x = pi & 7;
            attn_unit<128, 1>(lds, P1, 8192, 0, 2048, 4096, P1, 8192, 6144, (bf16_t*)(ws + WS_OG), 2048, 0, bh >> 4, bh & 15, 15 - x, (const float*)(ws + WS_CUML), (const float*)(ws + WS_BTOT), false);
            attn_unit<128, 1>(lds, P1, 8192, 0, 2048, 4096, P1, 8192, 6144, (bf16_t*)(ws + WS_OG), 2048, 0, bh >> 4, bh & 15, x, (const float*)(ws + WS_CUML), (const float*)(ws + WS_BTOT), true);
        }
    }
    SEAM(7);
    if (IN(8)) {
        pg8::Gemm g{(const bf16_t*)(ws + WS_OG), (const bf16_t*)(ws + WS_WO1T), M, 2048, 2048}; pg8::PanelOrder S; S.init(M, 2048, G, bx);
        if (G % 8 == 0) {
            pg8::EpiResNorm E{(const bf16_t*)(ws + WS_XB), a.out, (float*)(ws + WS_SSQ2), (unsigned*)(ws + WS_CNT), a.in[19]};
            pg8::gemm_phase<pg8::EpiResNorm, pg8::PanelOrder, true, true>(lds, g, S, E);
        } else {
            pg8::EpiRes E{nullptr, (const bf16_t*)(ws + WS_XB), a.out, nullptr, (float*)(ws + WS_SSQ2)};
            pg8::gemm_phase<pg8::EpiRes, pg8::PanelOrder, true, true>(lds, g, S, E);
            xcd_barrier(xbar);
            final_norm(a);
        }
    }
    if (DUP == 100) { for (int q = 0; q < 9; ++q) xcd_barrier(xbar); }
#undef IN
#undef SEAM
}

extern "C" void kernel_launch(void* const* d_in, const int* in_sizes, int n_in, void* d_out, int out_size, void* d_ws, size_t ws_size, hipStream_t stream) {
    static int grid = 0;
    if (grid == 0) {
        if (n_in != 20 || out_size != M * DM || ws_size < WS_END) { fprintf(stderr, "kernel_launch: unexpected shapes (n_in %d out %d ws %zu)\n", n_in, out_size, ws_size); grid = -1; return; }
        int dev = 0, cus = 0, per_cu = 0;
        (void)hipGetDevice(&dev);
        (void)hipDeviceGetAttribute(&cus, hipDeviceAttributeMultiprocessorCount, dev);
        (void)hipFuncSetAttribute((const void*)mega, hipFuncAttributeMaxDynamicSharedMemorySize, LDS_BYTES);
        (void)hipOccupancyMaxActiveBlocksPerMultiprocessor(&per_cu, (const void*)mega, 512, LDS_BYTES);
        if (per_cu < 1) per_cu = 1;
        grid = cus * per_cu;
        (void)hipGetLastError();
    }
    if (grid < 0) return;
    Args a{};
    for (int i = 0; i < 20; ++i) a.in[i] = (const float*)d_in[i];
    a.out = (float*)d_out; a.ws = (unsigned char*)d_ws; a.ph_lo = 0; a.ph_hi = 10;
    (void)hipMemsetAsync((unsigned char*)d_ws + WS_BAR, 0, XCD_BAR_WORDS * 4, stream);
    void* args[] = {&a};
    hipError_t e = hipLaunchCooperativeKernel((const void*)mega, dim3(grid), dim3(512), args, LDS_BYTES, stream);
    if (e != hipSuccess) fprintf(stderr, "cooperative launch failed: %s (grid %d)\n", hipGetErrorString(e), grid);
}
```

```cpp
#include <hip/hip_runtime.h>
#include <hip/hip_cooperative_groups.h>
#include <cstdio>
#include <cstdint>
namespace cg = cooperative_groups;
#define DI __device__ __forceinline__
#define LAS __attribute__((address_space(3)))
namespace pg8 {
#define PG8_LAS __attribute__((address_space(3)))
typedef unsigned short bf16_t;
typedef short bf16x8 __attribute__((ext_vector_type(8)));
typedef float f32x4 __attribute__((ext_vector_type(4)));
typedef unsigned u32x4 __attribute__((ext_vector_type(4)));
constexpr int BM = 256, BK = 64, HALF = 128, HTB = HALF * BK * 2  , STAGE_BYTES = 8 * HTB, NXCD = 8, WGM = 8;

__host__ __device__ __forceinline__ int lds_byte(int r, int c) { const int st = (r >> 4) * 2 + (c >> 5), rr = r & 15, cc = c & 31, ob = rr * 64 + cc * 2; return st * 1024 + (ob ^ (((ob >> 9) & 1) << 5)); }
__host__ __device__ __forceinline__ void stage_rc(int b, int& R, int& C) { const int st = b / 1024, sb = b % 1024, swz = sb ^ (((sb >> 9) & 1) << 5); R = (st >> 1) * 16 + swz / 64; C = (st & 1) * 32 + (swz % 64) / 2; }
__host__ __device__ __forceinline__ int perm32(int rho) { const int n = rho >> 4, i = rho & 15; return 8 * (i >> 2) + 4 * n + (i & 3); }

struct Unit { int pm, pn; };
struct Gemm { const bf16_t* A; const bf16_t* Bt; int M, N, K; };

struct StaticOrder {
    int nM, nN, nwg, G, c;
    __host__ __device__ void init(int M, int N, int G_, int c_) { nM = M / BM; nN = N / BM; nwg = nM * nN; G = G_; c = c_; }
    __host__ __device__ bool next(int i, Unit& u) const {
        const long L = (long)i * G + c; if (L >= nwg) return false;
        int wgid = (int)L; { const int q = nwg / NXCD, r = nwg % NXCD, xcd = wgid % NXCD, off = wgid / NXCD; wgid = (xcd < r ? xcd * (q + 1) : r * (q + 1) + (xcd - r) * q) + off; }
        const int nig = WGM * nN, gid = wgid / nig, fm = gid * WGM, gsz = (nM - fm) < WGM ? (nM - fm) : WGM;
        u.pm = fm + ((wgid % nig) % gsz); u.pn = (wgid % nig) / gsz; return true;
    }
    __device__ __forceinline__ void a_ready(const Unit&) const {}
    __device__ __forceinline__ void done(const Unit&) const {}
};


typedef unsigned u32x2 __attribute__((ext_vector_type(2)));
typedef float f32x2 __attribute__((ext_vector_type(2)));
typedef __bf16 bf16x2_t __attribute__((ext_vector_type(2)));
__device__ __forceinline__ unsigned cvtpk(float lo, float hi) { f32x2 v = {lo, hi}; bf16x2_t b = __builtin_convertvector(v, bf16x2_t); return __builtin_bit_cast(unsigned, b); }
__device__ __forceinline__ float bf_lo(unsigned u) { return __builtin_bit_cast(float, u << 16); }
__device__ __forceinline__ float bf_hi(unsigned u) { return __builtin_bit_cast(float, u & 0xffff0000u); }
__device__ __forceinline__ float sigm(float v) { return __builtin_amdgcn_rcpf(1.f + __expf(-v)); }

struct EpiProj {
    static constexpr bool PERM = true, AFTER_DRAIN = false;
    bf16_t* O; int ldc; const float* ssq; int qcols; float qscale;
    __device__ __forceinline__ void operator()(const f32x4 (&acc)[2][2][4][2], const Unit& u, int wr, int wc, int fr, int fq) const {
        const int row0 = u.pm * BM + wr * 64 + fr, col0 = u.pn * BM + wc * 32 + 8 * fq;
        const float cs = (u.pn * BM < qcols) ? qscale : 1.f;
#pragma unroll
        for (int ai = 0; ai < 2; ++ai)
#pragma unroll
            for (int m = 0; m < 4; ++m) {
                const int row = row0 + ai * HALF + m * 16;
                const float rs = cs / sqrtf(ssq[row] * (1.f / 2048.f) + 1e-6f);
                bf16_t* rowp = O + (size_t)row * ldc + col0;
#pragma unroll
                for (int bj = 0; bj < 2; ++bj) {
                    const f32x4 v0 = acc[ai][bj][m][0] * rs, v1 = acc[ai][bj][m][1] * rs;
                    u32x4 w; w.x = cvtpk(v0[0], v0[1]); w.y = cvtpk(v0[2], v0[3]); w.z = cvtpk(v1[0], v1[1]); w.w = cvtpk(v1[2], v1[3]);
                    *(u32x4*)(rowp + bj * HALF) = w;
                }
            }
    }
};

struct EpiGlu {
    static constexpr bool PERM = true, AFTER_DRAIN = false;
    const bf16_t* Y; int ldy; const bf16_t* ZB; int ldz; const float* bias; bf16_t* O; int ldo;
    __device__ __forceinline__ void operator()(const f32x4 (&acc)[2][2][4][2], const Unit& u, int wr, int wc, int fr, int fq) const {
        const int row0 = u.pm * BM + wr * 64 + fr, col0 = u.pn * BM + wc * 32 + 8 * fq;
#pragma unroll
        for (int ai = 0; ai < 2; ++ai)
#pragma unroll
            for (int m = 0; m < 4; ++m) {
                const int row = row0 + ai * HALF + m * 16;
#pragma unroll
                for (int bj = 0; bj < 2; ++bj) {
                    const int c = col0 + bj * HALF;
                    const u32x4 y8 = *(const u32x4*)(Y + (size_t)row * ldy + c), z8 = *(const u32x4*)(ZB + (size_t)row * ldz + c);
                    const f32x4 b0 = *(const f32x4*)(bias + c), b1 = *(const f32x4*)(bias + c + 4);
                    const f32x4 v0 = acc[ai][bj][m][0] + b0, v1 = acc[ai][bj][m][1] + b1;
                    float o[8];
#pragma unroll
                    for (int e = 0; e < 8; ++e) {
                        const unsigned yy = y8[e >> 1], zz = z8[e >> 1];
                        const float y = (e & 1) ? bf_hi(yy) : bf_lo(yy), z = (e & 1) ? bf_hi(zz) : bf_lo(zz);
                        const float v = e < 4 ? v0[e & 3] : v1[e & 3];
                        o[e] = y * sigm(v) * z * sigm(z);
                    }
                    u32x4 w; w.x = cvtpk(o[0], o[1]); w.y = cvtpk(o[2], o[3]); w.z = cvtpk(o[4], o[5]); w.w = cvtpk(o[6], o[7]);
                    *(u32x4*)(O + (size_t)row * ldo + c) = w;
                }
            }
    }
};

struct EpiRes {
    static constexpr bool PERM = true, AFTER_DRAIN = false;
    const float* R; const bf16_t* RB; float* OF; bf16_t* OB; float* ssq;
    __device__ __forceinline__ void operator()(const f32x4 (&acc)[2][2][4][2], const Unit& u, int wr, int wc, int fr, int fq) const {
        const int row0 = u.pm * BM + wr * 64 + fr, col0 = u.pn * BM + wc * 32 + 8 * fq;
#pragma unroll
        for (int ai = 0; ai < 2; ++ai) {
            f32x4 rr[4][2][2];
#pragma unroll
            for (int m = 0; m < 4; ++m)
#pragma unroll
                for (int bj = 0; bj < 2; ++bj) {
                    const size_t off = (size_t)(row0 + ai * HALF + m * 16) * 2048 + col0 + bj * HALF;
                    if (RB) { const u32x4 h = *(const u32x4*)(RB + off);
                        rr[m][bj][0] = (f32x4){bf_lo(h.x), bf_hi(h.x), bf_lo(h.y), bf_hi(h.y)}; rr[m][bj][1] = (f32x4){bf_lo(h.z), bf_hi(h.z), bf_lo(h.w), bf_hi(h.w)}; }
                    else { rr[m][bj][0] = *(const f32x4*)(R + off); rr[m][bj][1] = *(const f32x4*)(R + off + 4); }
                }
            __builtin_amdgcn_sched_barrier(0);
#pragma unroll
            for (int m = 0; m < 4; ++m) {
                const int row = row0 + ai * HALF + m * 16;
                float s = 0.f;
#pragma unroll
                for (int bj = 0; bj < 2; ++bj) {
                    const size_t off = (size_t)row * 2048 + col0 + bj * HALF;
                    const f32x4 v0 = acc[ai][bj][m][0] + rr[m][bj][0], v1 = acc[ai][bj][m][1] + rr[m][bj][1];
                    if (OF) { *(f32x4*)(OF + off) = v0; *(f32x4*)(OF + off + 4) = v1; }
                    if (OB) { u32x4 w; w.x = cvtpk(v0[0], v0[1]); w.y = cvtpk(v0[2], v0[3]); w.z = cvtpk(v1[0], v1[1]); w.w = cvtpk(v1[2], v1[3]); *(u32x4*)(OB + off) = w; }
                    s += (v0[0] * v0[0] + v0[1] * v0[1]) + (v0[2] * v0[2] + v0[3] * v0[3]) + (v1[0] * v1[0] + v1[1] * v1[1]) + (v1[2] * v1[2] + v1[3] * v1[3]);
                }
                s += __shfl_xor(s, 16); s += __shfl_xor(s, 32);
                if (fq == 0) atomicAdd(ssq + row, s);
            }
            __builtin_amdgcn_sched_barrier(0);
        }
    }
};

struct EpiResNorm {
    static constexpr bool PERM = true, AFTER_DRAIN = false;
    const bf16_t* RB; float* OF; float* ssq; unsigned* cnt; const float* gfin;
    __device__ __forceinline__ void operator()(f32x4 (&acc)[2][2][4][2], const Unit& u, int wr, int wc, int fr, int fq) const {
        const int row0 = u.pm * BM + wr * 64 + fr, col0 = u.pn * BM + wc * 32 + 8 * fq;
#pragma unroll
        for (int ai = 0; ai < 2; ++ai) {
            f32x4 rr[4][2][2];
#pragma unroll
            for (int m = 0; m < 4; ++m)
#pragma unroll
                for (int bj = 0; bj < 2; ++bj) {
                    const size_t off = (size_t)(row0 + ai * HALF + m * 16) * 2048 + col0 + bj * HALF;
                    const u32x4 h = *(const u32x4*)(RB + off);
                    rr[m][bj][0] = (f32x4){bf_lo(h.x), bf_hi(h.x), bf_lo(h.y), bf_hi(h.y)}; rr[m][bj][1] = (f32x4){bf_lo(h.z), bf_hi(h.z), bf_lo(h.w), bf_hi(h.w)};
                }
            __builtin_amdgcn_sched_barrier(0);
#pragma unroll
            for (int m = 0; m < 4; ++m) {
                const int row = row0 + ai * HALF + m * 16;
                float s = 0.f;
#pragma unroll
                for (int bj = 0; bj < 2; ++bj) {
                    const f32x4 v0 = acc[ai][bj][m][0] + rr[m][bj][0], v1 = acc[ai][bj][m][1] + rr[m][bj][1];
                    acc[ai][bj][m][0] = v0; acc[ai][bj][m][1] = v1;
                    s += (v0[0] * v0[0] + v0[1] * v0[1]) + (v0[2] * v0[2] + v0[3] * v0[3]) + (v1[0] * v1[0] + v1[1] * v1[1]) + (v1[2] * v1[2] + v1[3] * v1[3]);
                }
                s += __shfl_xor(s, 16); s += __shfl_xor(s, 32);
                if (fq == 0) atomicAdd(ssq + row, s);
            }
            __builtin_amdgcn_sched_barrier(0);
        }
        asm volatile("s_waitcnt vmcnt(0)" ::: "memory");
        __syncthreads();
        if (threadIdx.x == 0) {
            unsigned* c = cnt + 64 * u.pm;
            (void)__hip_atomic_fetch_add(c, 1u, __ATOMIC_RELAXED, __HIP_MEMORY_SCOPE_AGENT);
            unsigned sp = 0;
            while (__hip_atomic_load(c, __ATOMIC_RELAXED, __HIP_MEMORY_SCOPE_AGENT) < 8u) { __builtin_amdgcn_s_sleep(1); if (++sp > (1u << 22)) break; }
        }
        __syncthreads();
#pragma unroll
        for (int ai = 0; ai < 2; ++ai)
#pragma unroll
            for (int m = 0; m < 4; ++m) {
                const int row = row0 + ai * HALF + m * 16;
                const float rs = 1.f / sqrtf(__hip_atomic_load(ssq + row, __ATOMIC_RELAXED, __HIP_MEMORY_SCOPE_AGENT) * (1.f / 2048.f) + 1e-6f);
#pragma unroll
                for (int bj = 0; bj < 2; ++bj) {
                    const size_t off = (size_t)row * 2048 + col0 + bj * HALF;
                    const f32x4 g0 = *(const f32x4*)(gfin + col0 + bj * HALF), g1 = *(const f32x4*)(gfin + col0 + bj * HALF + 4);
                    *(f32x4*)(OF + off) = acc[ai][bj][m][0] * rs * g0; *(f32x4*)(OF + off + 4) = acc[ai][bj][m][1] * rs * g1;
                }
            }
    }
};

struct PanelOrder {
    int nwg, G, c, nN;
    __host__ __device__ void init(int M, int N, int G_, int c_) { nN = N / BM; nwg = (M / BM) * nN; G = G_; c = c_; }
    __host__ __device__ bool next(int i, Unit& u) const { const long L = (long)i * G + c; if (L >= nwg) return false; u.pm = (int)(L / nN); u.pn = (int)(L % nN); return true; }
    __device__ __forceinline__ void a_ready(const Unit&) const {}
    __device__ __forceinline__ void done(const Unit&) const {}
};
template <class Epi, class Sched, bool ALIGN_EPI = false, bool SP2 = false>
__device__ __forceinline__ void gemm_phase(PG8_LAS unsigned char* lds, const Gemm g, const Sched& S, const Epi& E) {
    const int tid = threadIdx.x, wid = __builtin_amdgcn_readfirstlane(tid >> 6), lane = tid & 63, wr = wid >> 2, wc = wid & 3, fr = lane & 15, fq = lane >> 4;
    const int K = g.K, nt = K / BK;
    unsigned voffA[2], voffB[2];
#pragma unroll
    for (int i = 0; i < 2; ++i) { int R, C; stage_rc(tid * 16 + i * 8192, R, C); const int Rb = Epi::PERM ? ((R & ~31) + perm32(R & 31)) : R;
        voffA[i] = (unsigned)(R * K + C) * 2u; voffB[i] = (unsigned)(Rb * K + C) * 2u; }
    const size_t kstep = (size_t)(BK * 2);
    const size_t hstep = (size_t)HALF * K * 2;
    const size_t tstep = 2 * hstep;
    const unsigned ldsw = (unsigned)wid * 1024u;
    const int aoff = lds_byte(wr * 64 + fr, fq * 8), boff = lds_byte(wc * 32 + fr, fq * 8);
#define PG8_SA(b, h) (((b) * 2 + (h)) * HTB)
#define PG8_SB(b, h) ((4 + (b) * 2 + (h)) * HTB)
#define PG8_STAGE(bufoff, gbase, voff) do { _Pragma("unroll") for (int _i = 0; _i < 2; ++_i) \
        __builtin_amdgcn_global_load_lds((const unsigned*)((const char*)(gbase) + (voff)[_i]), (PG8_LAS unsigned*)(lds + (bufoff) + ldsw + _i * 8192), 16, 0, 0); } while (0)
#define PG8_LDA(dst, b, h) do { _Pragma("unroll") for (int m = 0; m < 4; ++m) _Pragma("unroll") for (int k = 0; k < 2; ++k) dst[m][k] = *(const PG8_LAS bf16x8*)(lds + PG8_SA(b, h) + aoff + m * 2048 + k * 1024); } while (0)
#define PG8_LDB(dst, b, h) do { _Pragma("unroll") for (int n = 0; n < 2; ++n) _Pragma("unroll") for (int k = 0; k < 2; ++k) dst[n][k] = *(const PG8_LAS bf16x8*)(lds + PG8_SB(b, h) + boff + n * 2048 + k * 1024); } while (0)
#define PG8_MMA(ai, bj, At, Bt) do { __builtin_amdgcn_s_setprio(1); _Pragma("unroll") for (int m = 0; m < 4; ++m) _Pragma("unroll") for (int n = 0; n < 2; ++n) _Pragma("unroll") for (int k = 0; k < 2; ++k) \
        acc[ai][bj][m][n] = __builtin_amdgcn_mfma_f32_16x16x32_bf16(Bt[n][k], At[m][k], acc[ai][bj][m][n], 0, 0, 0); __builtin_amdgcn_s_setprio(0); } while (0)
#define PG8_WAIT_V(n) asm volatile("s_waitcnt vmcnt(" #n ")" ::: "memory")
#define PG8_WAIT_L(n) asm volatile("s_waitcnt lgkmcnt(" #n ")" ::: "memory")
#define PG8_BAR __builtin_amdgcn_s_barrier()
#define PG8_SCHED __builtin_amdgcn_sched_barrier(0)
    Unit cur, nxt; int ui = 0;
    if (!S.next(0, cur)) return;
    f32x4 acc[2][2][4][2];
#pragma unroll
    for (int a = 0; a < 2; ++a)
#pragma unroll
        for (int b = 0; b < 2; ++b)
#pragma unroll
            for (int m = 0; m < 4; ++m)
#pragma unroll
                for (int n = 0; n < 2; ++n) acc[a][b][m][n] = (f32x4){0.f, 0.f, 0.f, 0.f};
    bf16x8 At[4][2], B0[2][2], B1[2][2];
    const char* cA = (const char*)g.A + (size_t)cur.pm * tstep; const char* cB = (const char*)g.Bt + (size_t)cur.pn * tstep;
    S.a_ready(cur);
    if constexpr (SP2) {
        PG8_STAGE(PG8_SB(0, 0), cB, voffB); PG8_STAGE(PG8_SB(0, 1), cB + hstep, voffB); PG8_STAGE(PG8_SA(0, 0), cA, voffA); PG8_STAGE(PG8_SA(0, 1), cA + hstep, voffA);
        if (wr == 1) PG8_BAR;
        PG8_WAIT_V(2); PG8_BAR;
        PG8_STAGE(PG8_SB(1, 0), cB + kstep, voffB); PG8_STAGE(PG8_SA(1, 0), cA + kstep, voffA); PG8_STAGE(PG8_SB(1, 1), cB + hstep + kstep, voffB);
        PG8_WAIT_V(6); PG8_BAR;
    } else {
        PG8_STAGE(PG8_SB(0, 0), cB, voffB); PG8_STAGE(PG8_SA(0, 0), cA, voffA); PG8_STAGE(PG8_SB(0, 1), cB + hstep, voffB); PG8_STAGE(PG8_SA(0, 1), cA + hstep, voffA);
        if (wr == 1) PG8_BAR;
        PG8_WAIT_V(4); PG8_BAR;
        PG8_STAGE(PG8_SB(1, 0), cB + kstep, voffB); PG8_STAGE(PG8_SA(1, 0), cA + kstep, voffA); PG8_STAGE(PG8_SB(1, 1), cB + hstep + kstep, voffB);
        PG8_WAIT_V(6); PG8_BAR;
    }
    for (;;) {
        const bool has_next = S.next(ui + 1, nxt);
        const char* nA = has_next ? (const char*)g.A + (size_t)nxt.pm * tstep : cA; const char* nB = has_next ? (const char*)g.Bt + (size_t)nxt.pn * tstep : cB;
        for (int t = 0; t < nt; t += 2) {
            const bool last = (t == nt - 2);
            const char* a1 = cA + (size_t)(t + 1) * kstep;
            const char* a2 = last ? nA : cA + (size_t)(t + 2) * kstep; const char* b2 = last ? nB : cB + (size_t)(t + 2) * kstep;
            const char* a3 = a2 + kstep; const char* b3 = b2 + kstep;
            if (last && has_next) S.a_ready(nxt);
            if constexpr (SP2) {
            PG8_LDB(B0, 0, 0); PG8_LDB(B1, 0, 1); PG8_SCHED; PG8_LDA(At, 0, 0); PG8_STAGE(PG8_SA(1, 1), a1 + hstep, voffA);
            PG8_WAIT_V(8); PG8_WAIT_L(0); PG8_BAR; PG8_MMA(0, 0, At, B0); PG8_MMA(0, 1, At, B1); PG8_BAR; PG8_SCHED;
            PG8_LDA(At, 0, 1); PG8_STAGE(PG8_SB(0, 0), b2, voffB); PG8_STAGE(PG8_SB(0, 1), b2 + hstep, voffB); PG8_STAGE(PG8_SA(0, 0), a2, voffA);
            PG8_WAIT_V(8); PG8_WAIT_L(0); PG8_BAR; PG8_MMA(1, 0, At, B0); PG8_MMA(1, 1, At, B1); PG8_BAR; PG8_SCHED;
            PG8_LDB(B0, 1, 0); PG8_LDB(B1, 1, 1); PG8_SCHED; PG8_LDA(At, 1, 0); PG8_STAGE(PG8_SA(0, 1), a2 + hstep, voffA);
            PG8_WAIT_V(8); PG8_WAIT_L(0); PG8_BAR; PG8_MMA(0, 0, At, B0); PG8_MMA(0, 1, At, B1); PG8_BAR; PG8_SCHED;
            PG8_LDA(At, 1, 1); PG8_STAGE(PG8_SB(1, 0), b3, voffB); PG8_STAGE(PG8_SB(1, 1), b3 + hstep, voffB); PG8_STAGE(PG8_SA(1, 0), a3, voffA);
            PG8_WAIT_V(8); PG8_WAIT_L(0); PG8_BAR; PG8_MMA(1, 0, At, B0); PG8_MMA(1, 1, At, B1); PG8_BAR; PG8_SCHED;
            } else {
            PG8_LDB(B0, 0, 0); PG8_SCHED; PG8_LDA(At, 0, 0); PG8_STAGE(PG8_SA(1, 1), a1 + hstep, voffA);
            PG8_WAIT_L(8); PG8_BAR; PG8_WAIT_L(0); PG8_MMA(0, 0, At, B0); PG8_BAR; PG8_SCHED;
            PG8_LDB(B1, 0, 1); PG8_STAGE(PG8_SB(0, 0), b2, voffB);
            PG8_BAR; PG8_WAIT_L(0); PG8_MMA(0, 1, At, B1); PG8_BAR;
            PG8_LDA(At, 0, 1); PG8_STAGE(PG8_SA(0, 0), a2, voffA);
            PG8_BAR; PG8_WAIT_L(0); PG8_MMA(1, 0, At, B0); PG8_BAR; PG8_SCHED;
            PG8_STAGE(PG8_SB(0, 1), b2 + hstep, voffB);
            PG8_WAIT_V(6); PG8_BAR; PG8_MMA(1, 1, At, B1); PG8_BAR;
            PG8_LDB(B0, 1, 0); PG8_SCHED; PG8_LDA(At, 1, 0); PG8_STAGE(PG8_SA(0, 1), a2 + hstep, voffA);
            PG8_WAIT_L(8); PG8_BAR; PG8_WAIT_L(0); PG8_MMA(0, 0, At, B0); PG8_BAR; PG8_SCHED;
            PG8_LDB(B1, 1, 1); PG8_STAGE(PG8_SB(1, 0), b3, voffB);
            PG8_BAR; PG8_WAIT_L(0); PG8_MMA(0, 1, At, B1); PG8_BAR;
            PG8_LDA(At, 1, 1); PG8_STAGE(PG8_SA(1, 0), a3, voffA);
            PG8_BAR; PG8_WAIT_L(0); PG8_MMA(1, 0, At, B0); PG8_BAR; PG8_SCHED;
            PG8_STAGE(PG8_SB(1, 1), b3 + hstep, voffB);
            PG8_WAIT_V(6); PG8_BAR; PG8_MMA(1, 1, At, B1); PG8_BAR;
            }
        }
        if constexpr (ALIGN_EPI) { if (wr == 0) PG8_BAR; }
        if constexpr (!Epi::AFTER_DRAIN) { E(acc, cur, wr, wc, fr, fq); S.done(cur); }
        if (!has_next) break;
#pragma unroll
        for (int a = 0; a < 2; ++a)
#pragma unroll
            for (int b = 0; b < 2; ++b)
#pragma unroll
                for (int m = 0; m < 4; ++m)
#pragma unroll
                    for (int n = 0; n < 2; ++n) acc[a][b][m][n] = (f32x4){0.f, 0.f, 0.f, 0.f};
        cur = nxt; cA = nA; cB = nB; ++ui;
        if constexpr (ALIGN_EPI) { if (wr == 1) PG8_BAR; }
    }
    PG8_WAIT_V(0);
    if constexpr (!ALIGN_EPI) { if (wr == 0) PG8_BAR; }
    PG8_BAR;
    if constexpr (Epi::AFTER_DRAIN) { E.fused(acc, cur, wr, wc, fr, fq, lds, wid, lane); S.done(cur); }
#undef PG8_SA
#undef PG8_SB
#undef PG8_STAGE
#undef PG8_LDA
#undef PG8_LDB
#undef PG8_MMA
#undef PG8_WAIT_V
#undef PG8_WAIT_L
#undef PG8_BAR
#undef PG8_SCHED
}
}

using pg8::bf16_t; using pg8::bf16x8; using pg8::f32x4; using pg8::u32x4; using pg8::u32x2; using pg8::f32x2; using pg8::cvtpk; using pg8::bf_lo; using pg8::bf_hi; using pg8::sigm;
typedef short s16x4 __attribute__((ext_vector_type(4)));
typedef float f32x16 __attribute__((ext_vector_type(16)));
typedef short v4i16_t __attribute__((ext_vector_type(4)));
constexpr int M = 16384, DM = 2048, SEQ = 4096;
constexpr float LOG2E = 1.4426950408889634f;
constexpr size_t MiB = 1u << 20;
constexpr size_t WS_SSQ0 = 0, WS_SSQ1 = 65536, WS_SSQ2 = 131072, WS_BTOT = 196608, WS_BAR = 524288, WS_CNT = 327680, WS_S5TAB = 1048576;
constexpr int LDS_MISC = 143360;
constexpr size_t WS_W0T = 2 * MiB, WS_WGT = 26 * MiB, WS_WO0T = 28 * MiB, WS_W1T = 36 * MiB, WS_WFT = 68 * MiB, WS_WO1T = 69 * MiB;
constexpr size_t WS_S5ST = 77 * MiB, WS_CUML = 85 * MiB, WS_XB = 86 * MiB;
constexpr size_t WS_P0 = 150 * MiB, WS_YG = 342 * MiB, WS_MIX = 374 * MiB, WS_P1 = 150 * MiB, WS_OG = 438 * MiB, WS_END = 502 * MiB;
constexpr int LDS_BYTES = 147456;
#ifndef DUP
#define DUP -1
#endif
#define REP(k) for (int rep_ = 0; rep_ < ((DUP == (k)) ? 2 : 1); ++rep_)

struct Args { const float* in[20]; float* out; unsigned char* ws; int ph_lo, ph_hi; };

DI s16x4 vtr(LAS const unsigned char* p) { return __builtin_bit_cast(s16x4, __builtin_amdgcn_ds_read_tr16_b64_v4i16((LAS v4i16_t*)p)); }
DI float wave_sum(float v) {
#pragma unroll
    for (int o = 1; o < 64; o <<= 1) v += __shfl_xor(v, o);
    return v;
}

DI float xhalf_max(float v) { float a = v, b = v; asm volatile("v_nop\n\tv_nop\n\tv_permlane32_swap_b32 %0, %1" : "+v"(a), "+v"(b)); return fmaxf(a, b); }
DI float xhalf_sum(float v) { float a = v, b = v; asm volatile("v_nop\n\tv_nop\n\tv_permlane32_swap_b32 %0, %1" : "+v"(a), "+v"(b)); return a + b; }

template <int D, int MODE>
DI void attn_unit(LAS unsigned char* lds, const bf16_t* QKV, const int LD, const int qoff, const int koff, const int voff,
                  const bf16_t* Z, const int LDZ, const int zoff, bf16_t* OUT, const int LDO, const int ooff,
                  const int b, const int h, const int qb, const float* aux0, const float* aux1, const bool keep_aux) {
    constexpr int ROWBK = D * 2 + 16, ROWBV = (D == 128) ? 320 : 192, KT = 64 * ROWBK, VT = 64 * ROWBV, VOFF = 2 * KT, AUX = 2 * KT + 2 * VT;
    constexpr int NCH = D / 64, CPR = D / 8, NKS = D / 16, NDT = D / 32;
    constexpr float THR = 64.f, NEG = -1e30f;
    int tid_ = threadIdx.x; asm volatile("" : "+v"(tid_));
    const int tid = tid_, lane = tid & 63, w = __builtin_amdgcn_readfirstlane(tid >> 6), r = lane & 31, hh = lane >> 5;
    const size_t rowbase = (size_t)b * SEQ; const int q0 = qb * 256;
    LAS float* auxf = (LAS float*)(lds + AUX);
    int kt0, kt1, ci = 0;
    if (MODE == 0) { const int c0 = qb * 4; kt0 = c0 - 8 < 0 ? 0 : c0 - 8; kt1 = c0 + 4; ci = c0 + (w >> 1); }
    else { kt0 = 0; kt1 = q0 / 64 + 4; }
    u32x4 kreg[NCH], vreg[NCH];
    const bf16_t* kvbase = QKV + rowbase * LD + h * D;
#define ATT_GLOAD(kt) do { _Pragma("unroll") for (int i_ = 0; i_ < NCH; ++i_) { const int c_ = tid + 512 * i_, row_ = c_ / CPR, c8_ = c_ % CPR; \
        const bf16_t* g_ = kvbase + (size_t)((kt) * 64 + row_) * LD + c8_ * 8; kreg[i_] = *(const u32x4*)(g_ + koff); vreg[i_] = *(const u32x4*)(g_ + voff); } } while (0)
#define ATT_LSTORE(buf) do { _Pragma("unroll") for (int i_ = 0; i_ < NCH; ++i_) { const int c_ = tid + 512 * i_, row_ = c_ / CPR, c8_ = c_ % CPR; \
        *(LAS u32x4*)(lds + (buf) * KT + row_ * ROWBK + c8_ * 16) = kreg[i_]; *(LAS u32x4*)(lds + VOFF + (buf) * VT + row_ * ROWBV + c8_ * 16) = vreg[i_]; } } while (0)
    bf16x8 qf[NKS];
    {
        const bf16_t* qp = QKV + (rowbase + q0 + w * 32 + r) * LD + qoff + h * D + 8 * hh;
#pragma unroll
        for (int ks = 0; ks < NKS; ++ks) qf[ks] = *(const bf16x8*)(qp + ks * 16);
    }
    ATT_GLOAD(kt0);
    if (!keep_aux) {
        if (MODE == 0) {
            for (int i = tid; i < 257; i += 512) auxf[i] = aux0[h * 257 + i] * LOG2E;
        } else {
            LAS float* pref = auxf + 4096;
            if (w == 0) {
                const float own = aux1[(b * 64 + lane) * 16 + h]; float v = own;
#pragma unroll
                for (int o = 1; o < 64; o <<= 1) { const float t = __shfl_up(v, o); if (lane >= o) v += t; }
                pref[lane] = v - own;
            }
            __syncthreads();
            const float* cl = aux0 + (size_t)(b * 16 + h) * SEQ;
            const int nk = q0 + 256;
#pragma unroll 1
            for (int kb = 0; kb < nk; kb += 2048) {
                float c[4];
#pragma unroll
                for (int j = 0; j < 4; ++j) { const int k = kb + tid + 512 * j; c[j] = (k < nk) ? cl[k] : 0.f; }
#pragma unroll
                for (int j = 0; j < 4; ++j) { const int k = kb + tid + 512 * j; if (k < nk) auxf[k] = (c[j] + pref[k >> 6]) * -LOG2E; }
            }
        }
    }
    __builtin_amdgcn_s_waitcnt(0x0F70);
    asm volatile("" ::: "memory");
    ATT_LSTORE(0);
    { const int t1_ = kt0 + 1 < kt1 ? kt0 + 1 : kt0; ATT_GLOAD(t1_); }
    f32x16 O[NDT];
#pragma unroll
    for (int dt = 0; dt < NDT; ++dt)
#pragma unroll
        for (int i = 0; i < 16; ++i) O[dt][i] = 0.f;
    float mref = NEG, lrun = 0.f;
    __syncthreads();
    const int q4 = (lane & 15) >> 2, p4 = lane & 3, blk = (lane >> 4) & 1;
    const int qw = q0 + 32 * w;
    for (int kt = kt0; kt < kt1; ++kt) {
        const int buf = (kt - kt0) & 1;
        ATT_LSTORE(buf ^ 1);
        { const int t2_ = kt + 2 < kt1 ? kt + 2 : kt1 - 1; ATT_GLOAD(t2_); }
        bool active; int jrel = 0;
        if (MODE == 0) { jrel = ci - kt; active = (jrel >= 0 && jrel <= 8); } else { active = (kt * 64 <= qw); }
        if (active) {
            const int k0 = kt * 64;
            LAS const unsigned char* kp = lds + buf * KT + r * ROWBK + hh * 16;
            bf16x8 kf[2][4];
#define ATT_KLOAD(g_, slot_) do { _Pragma("unroll") for (int q_ = 0; q_ < 2; ++q_) { kf[slot_][2 * q_] = *(LAS const bf16x8*)(kp + (2 * (g_) + q_) * 32); kf[slot_][2 * q_ + 1] = *(LAS const bf16x8*)(kp + 32 * ROWBK + (2 * (g_) + q_) * 32); } } while (0)
            ATT_KLOAD(0, 0);
            f32x16 S0, S1;
            if (MODE == 1) {
                LAS const float* ckp = auxf + k0 + 4 * hh;
#pragma unroll
                for (int g = 0; g < 4; ++g) {
                    const f32x4 c0 = *(LAS const f32x4*)(ckp + 8 * g), c1 = *(LAS const f32x4*)(ckp + 32 + 8 * g);
#pragma unroll
                    for (int e = 0; e < 4; ++e) { S0[4 * g + e] = c0[e]; S1[4 * g + e] = c1[e]; }
                }
            } else {
                if (jrel >= 3) { const float bfar = auxf[256];
#pragma unroll
                    for (int i = 0; i < 16; ++i) { S0[i] = bfar; S1[i] = bfar; }
                } else {
                    const int base = jrel * 64 + (w & 1) * 32 + r + 128 - 4 * hh;
#pragma unroll
                    for (int i = 0; i < 16; ++i) { const int cr = (i & 3) + 8 * (i >> 2); int i0 = base - cr, i1 = base - 32 - cr; i0 = i0 > 256 ? 256 : i0; i1 = i1 > 256 ? 256 : i1; S0[i] = auxf[i0]; S1[i] = auxf[i1]; }
                }
            }
            __builtin_amdgcn_sched_barrier(0);
#pragma unroll
            for (int g = 0; g < NKS / 2; ++g) {
                if (g + 1 < NKS / 2) ATT_KLOAD(g + 1, (g + 1) & 1);
#pragma unroll
                for (int q = 0; q < 2; ++q) {
                    S0 = __builtin_amdgcn_mfma_f32_32x32x16_bf16(kf[g & 1][2 * q], qf[2 * g + q], S0, 0, 0, 0);
                    S1 = __builtin_amdgcn_mfma_f32_32x32x16_bf16(kf[g & 1][2 * q + 1], qf[2 * g + q], S1, 0, 0, 0);
                    if (DUP == 201 && MODE == 1) {
                        const bf16x8 n0 = kf[g & 1][2 * q] ^ (short)0x8000, n1 = kf[g & 1][2 * q + 1] ^ (short)0x8000;
                        S0 = __builtin_amdgcn_mfma_f32_32x32x16_bf16(n0, qf[2 * g + q], S0, 0, 0, 0); S1 = __builtin_amdgcn_mfma_f32_32x32x16_bf16(n1, qf[2 * g + q], S1, 0, 0, 0);
                        S0 = __builtin_amdgcn_mfma_f32_32x32x16_bf16(kf[g & 1][2 * q], qf[2 * g + q], S0, 0, 0, 0); S1 = __builtin_amdgcn_mfma_f32_32x32x16_bf16(kf[g & 1][2 * q + 1], qf[2 * g + q], S1, 0, 0, 0);
                    }
                }
                __builtin_amdgcn_sched_barrier(0);
            }
#undef ATT_KLOAD
            if (MODE == 1) {
                if (k0 + 63 > qw) {
                    const int lim = qw + r - k0;
#pragma unroll
                    for (int i = 0; i < 16; ++i) { const int kl = (i & 3) + 8 * (i >> 2) + 4 * hh; if (kl > lim) S0[i] = NEG; if (kl + 32 > lim) S1[i] = NEG; }
                }
            }
            float mx;
            asm volatile("s_nop 15\n\ts_nop 3\n\tv_max3_f32 %0, %1, %2, %3" : "=v"(mx) : "v"(S0[0]), "v"(S1[0]), "v"(S0[1]));
#pragma unroll
            for (int i = 1; i < 15; ++i) asm volatile("v_max3_f32 %0, %0, %1, %2" : "+v"(mx) : "v"(S1[i]), "v"(S0[i + 1]));
            asm volatile("v_max_f32 %0, %0, %1" : "+v"(mx) : "v"(S1[15]));
            mx = xhalf_max(mx);
            if (__any(mx > mref + THR)) {
                const float mnew = fmaxf(mref, mx);
                const float alpha = __builtin_amdgcn_exp2f(mref - mnew);
                mref = mnew; lrun *= alpha;
#pragma unroll
                for (int dt = 0; dt < NDT; ++dt)
#pragma unroll
                    for (int i = 0; i < 16; ++i) O[dt][i] *= alpha;
            }
            float ps = 0.f;
#pragma unroll
            for (int i = 0; i < 16; ++i) { S0[i] = __builtin_amdgcn_exp2f(S0[i] - mref); S1[i] = __builtin_amdgcn_exp2f(S1[i] - mref); ps += S0[i] + S1[i]; }
            lrun += ps;
            bf16x8 pf[4];
#pragma unroll
            for (int s = 0; s < 2; ++s) {
                u32x4 pk; pk.x = cvtpk(S0[8 * s], S0[8 * s + 1]); pk.y = cvtpk(S0[8 * s + 2], S0[8 * s + 3]); pk.z = cvtpk(S0[8 * s + 4], S0[8 * s + 5]); pk.w = cvtpk(S0[8 * s + 6], S0[8 * s + 7]); pf[s] = __builtin_bit_cast(bf16x8, pk);
                u32x4 pq; pq.x = cvtpk(S1[8 * s], S1[8 * s + 1]); pq.y = cvtpk(S1[8 * s + 2], S1[8 * s + 3]); pq.z = cvtpk(S1[8 * s + 4], S1[8 * s + 5]); pq.w = cvtpk(S1[8 * s + 6], S1[8 * s + 7]); pf[2 + s] = __builtin_bit_cast(bf16x8, pq);
            }
            __builtin_amdgcn_sched_barrier(0);
            LAS const unsigned char* vp = lds + VOFF + buf * VT + (4 * hh + q4) * ROWBV + blk * 32 + p4 * 8;
            s16x4 vlo[2][4], vhi[2][4];
#define ATT_VLOAD(dt_, slot_) do { _Pragma("unroll") for (int kk_ = 0; kk_ < 4; ++kk_) { vlo[slot_][kk_] = vtr(vp + (16 * kk_) * ROWBV + (dt_) * 64); vhi[slot_][kk_] = vtr(vp + (16 * kk_ + 8) * ROWBV + (dt_) * 64); } } while (0)
            ATT_VLOAD(0, 0);
            __builtin_amdgcn_sched_barrier(0);
#pragma unroll
            for (int dt = 0; dt < NDT; ++dt) {
                if (dt + 1 < NDT) ATT_VLOAD(dt + 1, (dt + 1) & 1);
#pragma unroll
                for (int kk = 0; kk < 4; ++kk) {
                    const bf16x8 vf = __builtin_shufflevector(vlo[dt & 1][kk], vhi[dt & 1][kk], 0, 1, 2, 3, 4, 5, 6, 7);
                    O[dt] = __builtin_amdgcn_mfma_f32_32x32x16_bf16(vf, pf[kk], O[dt], 0, 0, 0);
                }
                __builtin_amdgcn_sched_barrier(0);
            }
#undef ATT_VLOAD
        }
        asm volatile("s_waitcnt lgkmcnt(0)\n\ts_barrier" ::: "memory");
    }
#undef ATT_GLOAD
#undef ATT_LSTORE
    const float inv = 1.f / xhalf_sum(lrun);
    int lane2 = lane; asm volatile("" : "+v"(lane2));
    LAS unsigned char* st = lds + w * 32 * ROWBK;
    constexpr int NIT = 32 * CPR / 64;
    u32x4 zq[NIT];
#pragma unroll
    for (int it = 0; it < NIT; ++it) { const int idx = it * 64 + lane2, row = idx / CPR, c8 = idx % CPR; zq[it] = *(const u32x4*)(Z + (rowbase + q0 + w * 32 + row) * LDZ + zoff + h * D + c8 * 8); }
#pragma unroll
    for (int dt = 0; dt < NDT; ++dt)
#pragma unroll
        for (int g = 0; g < 4; ++g) {
            u32x2 pk; pk.x = cvtpk(O[dt][4 * g] * inv, O[dt][4 * g + 1] * inv); pk.y = cvtpk(O[dt][4 * g + 2] * inv, O[dt][4 * g + 3] * inv);
            *(LAS u32x2*)(st + (lane2 & 31) * ROWBK + (dt * 32 + 8 * g + 4 * (lane2 >> 5)) * 2) = pk;
        }
    asm volatile("s_waitcnt lgkmcnt(0)" ::: "memory");
#pragma unroll
    for (int it = 0; it < NIT; ++it) {
        const int idx = it * 64 + lane2, row = idx / CPR, c8 = idx % CPR;
        const u32x4 o8 = *(LAS const u32x4*)(st + row * ROWBK + c8 * 16);
        const size_t grow = rowbase + q0 + w * 32 + row;
        const u32x4 z8 = zq[it];
        u32x4 res;
#pragma unroll
        for (int e = 0; e < 4; ++e) {
            const float o0 = bf_lo(o8[e]), o1 = bf_hi(o8[e]), z0 = bf_lo(z8[e]), z1 = bf_hi(z8[e]);
            res[e] = cvtpk(o0 * z0 * sigm(z0), o1 * z1 * sigm(z1));
        }
        *(u32x4*)(OUT + grow * LDO + ooff + h * D + c8 * 8) = res;
    }
    __syncthreads();
}

DI double exp_d(double z) {
    const double n = rint(z * 1.4426950408889634074);
    const double rr = (z - n * 6.93147180369123816490e-01) - n * 1.90821492927058770002e-10;
    double p = 1.0 / 39916800.0;
    p = p * rr + 1.0 / 3628800.0; p = p * rr + 1.0 / 362880.0; p = p * rr + 1.0 / 40320.0; p = p * rr + 1.0 / 5040.0; p = p * rr + 1.0 / 720.0;
    p = p * rr + 1.0 / 120.0; p = p * rr + 1.0 / 24.0; p = p * rr + 1.0 / 6.0; p = p * rr + 0.5; p = p * rr + 1.0; p = p * rr + 1.0;
    const long long bits = (long long)(1023 + (int)n) << 52;
    return p * __builtin_bit_cast(double, bits);
}
DI void sincos_d(double x, double& sn, double& cs) {
    const double k = rint(x * 0.63661977236758134308);
    const double rr = (x - k * 1.57079632673412561417e+00) - k * 6.07710050650619224932e-11;
    const double r2 = rr * rr;
    double s = 1.0 / 6227020800.0; s = s * r2 - 1.0 / 39916800.0; s = s * r2 + 1.0 / 362880.0; s = s * r2 - 1.0 / 5040.0; s = s * r2 + 1.0 / 120.0; s = s * r2 - 1.0 / 6.0; s = rr + rr * r2 * s;
    double c = -1.0 / 87178291200.0; c = c * r2 + 1.0 / 479001600.0; c = c * r2 - 1.0 / 3628800.0; c = c * r2 + 1.0 / 40320.0; c = c * r2 - 1.0 / 720.0; c = c * r2 + 1.0 / 24.0; c = c * r2 - 0.5; c = 1.0 + c * r2;
    const int q = ((int)k) & 3;
    sn = (q == 0) ? s : (q == 1) ? c : (q == 2) ? -s : -c;
    cs = (q == 0) ? c : (q == 1) ? -s : (q == 2) ? -c : s;
}

template <bool P2>
DI void s5_pass(LAS unsigned char* lds, const Args& a) {
    const int tid = threadIdx.x, lane = tid & 63, w = __builtin_amdgcn_readfirstlane(tid >> 6), r = lane & 31, hh = lane >> 5;
    LAS unsigned char* stl = lds + w * 9216;
    const bf16_t* P0 = (const bf16_t*)(a.ws + WS_P0);
    f32x2* S5ST = (f32x2*)(a.ws + WS_S5ST);
    bf16_t* YG = (bf16_t*)(a.ws + WS_YG);
    const int hhrow = (r >> 2) & 1, irow = (r & 3) + 4 * (r >> 3);
    for (int task = blockIdx.x; task < 1024; task += gridDim.x) {
        const int g8 = task & 7, c = (task >> 3) & 63, bp = task >> 9;
        const int g = g8 * 8 + w;
        const int b = bp * 2 + hh;
        float are[2], aim[2], xr[2], xi[2], a64r[2], a64i[2];
        bf16x8 bfrag[2][2];
#pragma unroll
        for (int ps = 0; ps < 2; ++ps) {
            const int p = r + 32 * ps;
            const f32x4* tp = (const f32x4*)(a.ws + WS_S5TAB) + (size_t)(g * 64 + p) * 2;
            const f32x4 t0 = tp[0], t1 = tp[1];
            are[ps] = t0[0]; aim[ps] = t0[1];
            const float cre = t0[2], cim = t0[3];
            const f32x4* br = (const f32x4*)(a.in[7] + (size_t)(g * 64 + p) * 16 + 8 * hh); const f32x4* bi = (const f32x4*)(a.in[8] + (size_t)(g * 64 + p) * 16 + 8 * hh);
            const f32x4 x0 = br[0], x1 = br[1], y0 = bi[0], y1 = bi[1];
            u32x4 kr, ki;
            kr.x = cvtpk(cre * x0[0] - cim * y0[0], cre * x0[1] - cim * y0[1]); kr.y = cvtpk(cre * x0[2] - cim * y0[2], cre * x0[3] - cim * y0[3]);
            kr.z = cvtpk(cre * x1[0] - cim * y1[0], cre * x1[1] - cim * y1[1]); kr.w = cvtpk(cre * x1[2] - cim * y1[2], cre * x1[3] - cim * y1[3]);
            ki.x = cvtpk(cre * y0[0] + cim * x0[0], cre * y0[1] + cim * x0[1]); ki.y = cvtpk(cre * y0[2] + cim * x0[2], cre * y0[3] + cim * x0[3]);
            ki.z = cvtpk(cre * y1[0] + cim * x1[0], cre * y1[1] + cim * x1[1]); ki.w = cvtpk(cre * y1[2] + cim * x1[2], cre * y1[3] + cim * x1[3]);
            bfrag[0][ps] = __builtin_bit_cast(bf16x8, kr); bfrag[1][ps] = __builtin_bit_cast(bf16x8, ki);
            xr[ps] = 0.f; xi[ps] = 0.f;
            a64r[ps] = t1[0]; a64i[ps] = t1[1];
        }
        bf16x8 cf[4]; f32x4 dsk = {0.f, 0.f, 0.f, 0.f};
        const int tl = lane & 15, kq = lane >> 4;
        if (P2) {
            const f32x2* se = S5ST + ((size_t)(b * 64) * 64 + g) * 64 + r;
#pragma unroll 4
            for (int cc = 0; cc < c; ++cc) {
                const f32x2 e0 = se[(size_t)cc * 4096], e1 = se[(size_t)cc * 4096 + 32];
                const float n0r = a64r[0] * xr[0] - a64i[0] * xi[0] + e0.x, n0i = a64r[0] * xi[0] + a64i[0] * xr[0] + e0.y;
                const float n1r = a64r[1] * xr[1] - a64i[1] * xi[1] + e1.x, n1i = a64r[1] * xi[1] + a64i[1] * xr[1] + e1.y;
                xr[0] = n0r; xi[0] = n0i; xr[1] = n1r; xi[1] = n1i;
            }
#pragma unroll
            for (int kk = 0; kk < 4; ++kk) {
                const size_t off = (size_t)(g * 16 + tl) * 64 + kk * 16 + 4 * kq;
                const f32x4 re = *(const f32x4*)(a.in[9] + off), im = *(const f32x4*)(a.in[10] + off);
                u32x4 pk; pk.x = cvtpk(re[0], -im[0]); pk.y = cvtpk(re[1], -im[1]); pk.z = cvtpk(re[2], -im[2]); pk.w = cvtpk(re[3], -im[3]);
                cf[kk] = __builtin_bit_cast(bf16x8, pk);
            }
            dsk = *(const f32x4*)(a.in[11] + g * 16 + 4 * kq);
        }
        const bf16_t* ubase = P0 + ((size_t)(bp * 2 + hhrow) * SEQ + c * 64 + irow) * 6144 + 3072 + g * 16 + 8 * hh;
        bf16x8 af[4];
#pragma unroll
        for (int rbk = 0; rbk < 4; ++rbk) af[rbk] = *(const bf16x8*)(ubase + (size_t)rbk * 16 * 6144);
        u32x2 usk[4][2];
        if (P2) {
#pragma unroll
            for (int rbk = 0; rbk < 4; ++rbk)
#pragma unroll
                for (int h2 = 0; h2 < 2; ++h2) usk[rbk][h2] = *(const u32x2*)(P0 + ((size_t)(bp * 2 + h2) * SEQ + c * 64 + rbk * 16 + tl) * 6144 + 3072 + g * 16 + 4 * kq);
        }
#pragma unroll
        for (int rbk = 0; rbk < 4; ++rbk) {
            f32x16 Dv[2][2];
#pragma unroll
            for (int part = 0; part < 2; ++part)
#pragma unroll
                for (int ps = 0; ps < 2; ++ps) {
                    f32x16 z;
#pragma unroll
                    for (int i = 0; i < 16; ++i) z[i] = 0.f;
                    Dv[part][ps] = __builtin_amdgcn_mfma_f32_32x32x16_bf16(af[rbk], bfrag[part][ps], z, 0, 0, 0);
                }
#pragma unroll
            for (int i = 0; i < 16; ++i) {
#pragma unroll
                for (int ps = 0; ps < 2; ++ps) {
                    const float nxr = are[ps] * xr[ps] - aim[ps] * xi[ps] + Dv[0][ps][i], nxi = are[ps] * xi[ps] + aim[ps] * xr[ps] + Dv[1][ps][i];
                    xr[ps] = nxr; xi[ps] = nxi;
                    if (P2) *(LAS unsigned*)(stl + hh * 4352 + i * 272 + (r + 32 * ps) * 4) = cvtpk(nxr, nxi);
                }
            }
            if (P2) {
                asm volatile("s_waitcnt lgkmcnt(0)" ::: "memory");
#pragma unroll
                for (int h2 = 0; h2 < 2; ++h2) {
                    f32x4 acc = {0.f, 0.f, 0.f, 0.f};
#pragma unroll
                    for (int kk = 0; kk < 4; ++kk) { const bf16x8 xb = *(LAS const bf16x8*)(stl + h2 * 4352 + tl * 272 + kk * 64 + kq * 16); acc = __builtin_amdgcn_mfma_f32_16x16x32_bf16(cf[kk], xb, acc, 0, 0, 0); }
                    const size_t row = (size_t)(bp * 2 + h2) * SEQ + c * 64 + rbk * 16 + tl;
                    const u32x2 u4 = usk[rbk][h2];
                    float y[4]; y[0] = acc[0] + dsk[0] * bf_lo(u4.x); y[1] = acc[1] + dsk[1] * bf_hi(u4.x); y[2] = acc[2] + dsk[2] * bf_lo(u4.y); y[3] = acc[3] + dsk[3] * bf_hi(u4.y);
#pragma unroll
                    for (int e = 0; e < 4; ++e) { const float v = y[e]; const float z2 = 1.5957691216057308f * (v + 0.044715f * v * v * v); y[e] = v * sigm(z2); }
                    u32x2 o; o.x = cvtpk(y[0], y[1]); o.y = cvtpk(y[2], y[3]);
                    *(u32x2*)(YG + row * 1024 + g * 16 + 4 * kq) = o;
                }
                asm volatile("s_waitcnt lgkmcnt(0)" ::: "memory");
            }
        }
        if (!P2) {
#pragma unroll
            for (int ps = 0; ps < 2; ++ps) { f32x2 e; e.x = xr[ps]; e.y = xi[ps]; S5ST[((size_t)(b * 64 + c) * 64 + g) * 64 + r + 32 * ps] = e; }
        }
    }
}

DI void transpose_item(const float* W, int ld, int K, int nvalid, const float* gk, bf16_t* WT, int kb, int n0, int lane) {
    const int n = n0 + lane, k0 = kb * 32;
    if (n < nvalid) {
        const float* wp = W + (size_t)k0 * ld + n;
        float v[32];
#pragma unroll
        for (int e = 0; e < 32; ++e) v[e] = __builtin_nontemporal_load(wp + (size_t)e * ld);
        if (gk) {
#pragma unroll
            for (int e = 0; e < 32; ++e) v[e] *= gk[k0 + e];
        }
        u32x4* dst = (u32x4*)(WT + (size_t)n * K + k0);
#pragma unroll
        for (int q = 0; q < 4; ++q) { u32x4 o; o.x = cvtpk(v[8 * q], v[8 * q + 1]); o.y = cvtpk(v[8 * q + 2], v[8 * q + 3]); o.z = cvtpk(v[8 * q + 4], v[8 * q + 5]); o.w = cvtpk(v[8 * q + 6], v[8 * q + 7]); dst[q] = o; }
    }
}

DI void prologue(LAS unsigned char* lds, const Args& a) {
    const int tid = threadIdx.x, lane = tid & 63, w = __builtin_amdgcn_readfirstlane(tid >> 6);
    const int gw = blockIdx.x * 8 + w, NGW = gridDim.x * 8;
    unsigned char* ws = a.ws;
    constexpr int I0 = 96 * 64, I1 = 16 * 32, I2 = 32 * 64, I3 = 128 * 64, I4 = 64, I5 = 32 * 64, NIT = I0 + I1 + I2 + I3 + I4 + I5;
#pragma unroll 1
    for (int it = gw; it < NIT; it += NGW) {
        int q = it;
        if (q < I0) { transpose_item(a.in[2], 6144, 2048, 6144, a.in[1], (bf16_t*)(ws + WS_W0T), q & 63, (q >> 6) * 64, lane); continue; } q -= I0;
        if (q < I1) { transpose_item(a.in[12], 1024, 1024, 1024, nullptr, (bf16_t*)(ws + WS_WGT), q & 31, (q >> 5) * 64, lane); continue; } q -= I1;
        if (q < I2) { transpose_item(a.in[14], 2048, 2048, 2048, nullptr, (bf16_t*)(ws + WS_WO0T), q & 63, (q >> 6) * 64, lane); continue; } q -= I2;
        if (q < I3) { transpose_item(a.in[16], 8208, 2048, 8192, a.in[15], (bf16_t*)(ws + WS_W1T), q & 63, (q >> 6) * 64, lane); continue; } q -= I3;
        if (q < I4) { transpose_item(a.in[16] + 8192, 8208, 2048, 16, a.in[15], (bf16_t*)(ws + WS_WFT), q, 0, lane); continue; } q -= I4;
        transpose_item(a.in[18], 2048, 2048, 2048, nullptr, (bf16_t*)(ws + WS_WO1T), q & 63, (q >> 6) * 64, lane);
    }
    float* ssq0 = (float*)(ws + WS_SSQ0); bf16_t* XB = (bf16_t*)(ws + WS_XB);
    for (int m = gw; m < M; m += NGW) {
        const f32x4* xr = (const f32x4*)(a.in[0] + (size_t)m * DM) + lane;
        f32x4 v[8]; float s = 0.f;
#pragma unroll
        for (int j = 0; j < 8; ++j) { v[j] = __builtin_nontemporal_load(xr + 64 * j); s += (v[j][0] * v[j][0] + v[j][1] * v[j][1]) + (v[j][2] * v[j][2] + v[j][3] * v[j][3]); }
        s = wave_sum(s);
        u32x2* o8 = (u32x2*)(XB + (size_t)m * DM) + lane;
#pragma unroll
        for (int j = 0; j < 8; ++j) { u32x2 o; o.x = cvtpk(v[j][0], v[j][1]); o.y = cvtpk(v[j][2], v[j][3]); o8[64 * j] = o; }
        if (lane == 0) ssq0[m] = s;
    }
    for (int i = blockIdx.x * 512 + tid; i < 4096; i += gridDim.x * 512) {
        const int g = i >> 6;
        const double lr = (double)a.in[4][i], li = (double)a.in[5][i];
        const double dt = exp_d((double)a.in[6][g]);
        const double mag = exp_d(lr * dt);
        double sn, cs; sincos_d(li * dt, sn, cs);
        const double dare = mag * cs, daim = mag * sn;
        const double nr = dare - 1.0, ni = daim, den = lr * lr + li * li;
        double pr = dare, pi = daim;
#pragma unroll
        for (int q = 0; q < 6; ++q) { const double tr = pr * pr - pi * pi, ti = 2.0 * pr * pi; pr = tr; pi = ti; }
        f32x4 t0, t1; t0[0] = (float)dare; t0[1] = (float)daim; t0[2] = (float)((nr * lr + ni * li) / den); t0[3] = (float)((ni * lr - nr * li) / den);
        t1[0] = (float)pr; t1[1] = (float)pi; t1[2] = 0.f; t1[3] = 0.f;
        f32x4* tp = (f32x4*)(ws + WS_S5TAB) + (size_t)i * 2; tp[0] = t0; tp[1] = t1;
    }
    float* ssq1 = (float*)(ws + WS_SSQ1); float* ssq2 = (float*)(ws + WS_SSQ2);
    for (int i = blockIdx.x * 512 + tid; i < M; i += gridDim.x * 512) { ssq1[i] = 0.f; ssq2[i] = 0.f; }
    if (blockIdx.x == 0) for (int i = tid; i < 64 * 64; i += 512) ((unsigned*)(ws + WS_CNT))[i] = 0u;
}

DI void flogit_phase(LAS unsigned char* lds, const Args& a) {
    const int tid = threadIdx.x, lane = tid & 63, w = __builtin_amdgcn_readfirstlane(tid >> 6);
    const bf16_t* X1B = (const bf16_t*)(a.ws + WS_XB); const bf16_t* WFT = (const bf16_t*)(a.ws + WS_WFT);
    const float* ssq1 = (const float*)(a.ws + WS_SSQ1);
    float* cuml = (float*)(a.ws + WS_CUML); float* btot = (float*)(a.ws + WS_BTOT);
    LAS float* part = (LAS float*)lds;
    LAS float* lf = part + 1024;
    const int rg = w & 3, kh = w >> 2, l15 = lane & 15, kq = lane >> 4;
    for (int rb = blockIdx.x; rb < M / 64; rb += gridDim.x) {
        const size_t R0 = (size_t)rb * 64 + rg * 16;
        const bf16_t* ap = X1B + (R0 + l15) * DM + kh * 1024 + 8 * kq;
        const bf16_t* bp = WFT + (size_t)l15 * DM + kh * 1024 + 8 * kq;
        f32x4 acc = {0.f, 0.f, 0.f, 0.f};
#pragma unroll 8
        for (int kk = 0; kk < 32; ++kk) { const bf16x8 af = *(const bf16x8*)(ap + kk * 32), bf = *(const bf16x8*)(bp + kk * 32); acc = __builtin_amdgcn_mfma_f32_16x16x32_bf16(af, bf, acc, 0, 0, 0); }
        if (kh == 1) {
#pragma unroll
            for (int e = 0; e < 4; ++e) part[rg * 256 + (4 * kq + e) * 16 + l15] = acc[e];
        }
        __syncthreads();
        if (kh == 0) {
            const float bfg = a.in[17][l15];
#pragma unroll
            for (int e = 0; e < 4; ++e) {
                const int tok = 4 * kq + e; const size_t row = R0 + tok;
                const float rs = 1.f / sqrtf(ssq1[row] * (1.f / 2048.f) + 1e-6f);
                const float f = (acc[e] + part[rg * 256 + tok * 16 + l15]) * rs + bfg;
                const float ls = fminf(f, 0.f) - log1pf(__expf(-fabsf(f)));
                lf[(rg * 16 + tok) * 16 + l15] = ls;
            }
        }
        __syncthreads();
        if (tid < 16) {
            const int bb = rb >> 6, t0 = (rb & 63) * 64; float cum = 0.f;
            float* cp = cuml + (size_t)(bb * 16 + tid) * SEQ + t0;
            for (int i = 0; i < 64; ++i) { cum += lf[i * 16 + tid]; cp[i] = cum; }
            btot[rb * 16 + tid] = cum;
        }
        __syncthreads();
    }
}

DI void final_norm(const Args& a) {
    const int tid = threadIdx.x, lane = tid & 63, w = tid >> 6;
    const int gw = blockIdx.x * 8 + w, NGW = gridDim.x * 8;
    const float* ssq2 = (const float*)(a.ws + WS_SSQ2);
    const f32x4* gp = (const f32x4*)a.in[19] + lane;
    for (int m = gw; m < M; m += NGW) {
        const float rs = 1.f / sqrtf(ssq2[m] * (1.f / 2048.f) + 1e-6f);
        f32x4* xr = (f32x4*)(a.out + (size_t)m * DM) + lane;
#pragma unroll
        for (int j = 0; j < 8; ++j) { f32x4 v = xr[64 * j]; const f32x4 g = gp[64 * j]; v = v * rs * g; xr[64 * j] = v; }
    }
}

#define XB_TMO      128
#define XB_XCNT(j)  (256  + 64 * (j))
#define XB_XSUB(j)  (1280 + 64 * (j))
#define XB_XGEN(j)  (2304 + 64 * (j))
#define XB_TOP      3328
#define XB_TOPGEN   3392
#define XCD_BAR_WORDS 3456
#define XB_SPIN_CAP (1u << 18)

__device__ __forceinline__ unsigned xb_ld(unsigned* p)              { return __hip_atomic_load(p, __ATOMIC_RELAXED, __HIP_MEMORY_SCOPE_AGENT); }
__device__ __forceinline__ unsigned xb_add(unsigned* p, unsigned v) { return __hip_atomic_fetch_add(p, v, __ATOMIC_RELAXED, __HIP_MEMORY_SCOPE_AGENT); }
__device__ __forceinline__ unsigned xb_xcc_id() { return (unsigned)__builtin_amdgcn_s_getreg((3 << 11) | 20) & 0xFu; }
#define XB_SPIN(cond, bar) do { unsigned _sp = 0; while (cond) { __builtin_amdgcn_s_sleep(1); \
    if ((++_sp & 255u) == 0u) { if (xb_ld(&(bar)[XB_TMO])) break; if (_sp > XB_SPIN_CAP) { atomicAdd(&(bar)[XB_TMO], 1u); break; } } } } while (0)

struct XcdBarrier {
    unsigned* bar; unsigned x;
    volatile LAS unsigned* st;
};

__device__ __forceinline__ XcdBarrier xcd_barrier_post(unsigned* bar, volatile LAS unsigned* st) {
    XcdBarrier b; b.bar = bar; b.x = xb_xcc_id(); b.st = st;
    if (threadIdx.x == 0) (void)xb_add(&bar[XB_XCNT(b.x)], 1u);
    return b;
}
__device__ __forceinline__ void xcd_barrier_complete(unsigned* bar, unsigned x, unsigned& nloc, unsigned& nx) {
    const unsigned G = gridDim.x * gridDim.y * gridDim.z;
    unsigned sum, cnt, mine, sp = 0u;
    for (;;) {
        sum = 0u; cnt = 0u; mine = 0u;
#pragma unroll
        for (unsigned j = 0; j < 16; ++j) { const unsigned c = xb_ld(&bar[XB_XCNT(j)]); sum += c; cnt += (c > 0u) ? 1u : 0u; mine = (j == x) ? c : mine; }
        if (sum == G) break;
        __builtin_amdgcn_s_sleep(1);
        if ((++sp & 255u) == 0u) { if (xb_ld(&bar[XB_TMO])) break; if (sp > XB_SPIN_CAP) { atomicAdd(&bar[XB_TMO], 1u); break; } }
    }
    nloc = mine > 0u ? mine : 1u; nx = cnt > 0u ? cnt : 1u;
}

__device__ __forceinline__ void xcd_barrier(const XcdBarrier& b) {
    asm volatile("s_waitcnt vmcnt(0)" ::: "memory");
    __syncthreads();
    if (threadIdx.x == 0) {
        unsigned* bar = b.bar;
        __builtin_amdgcn_s_waitcnt(0);
        unsigned nloc = b.st[0], nx = b.st[1];
        if (nloc == 0u) { xcd_barrier_complete(bar, b.x, nloc, nx); b.st[0] = nloc; b.st[1] = nx; }
        const unsigned old = xb_add(&bar[XB_XSUB(b.x)], 1u);
        const unsigned gen = old / nloc;
        if (old + 1u == (gen + 1u) * nloc) {
            __builtin_amdgcn_fence(__ATOMIC_RELEASE, "agent");
            asm volatile("s_waitcnt vmcnt(0)" ::: "memory");
            const unsigned og = xb_add(&bar[XB_TOP], 1u);
            const unsigned tg = og / nx;
            if (og + 1u == (tg + 1u) * nx) xb_add(&bar[XB_TOPGEN], 1u);
            else XB_SPIN(xb_ld(&bar[XB_TOPGEN]) == tg, bar);
            __builtin_amdgcn_fence(__ATOMIC_ACQUIRE, "agent");
            xb_add(&bar[XB_XGEN(b.x)], 1u);
            asm volatile("s_waitcnt vmcnt(0)" ::: "memory");
        } else {
            XB_SPIN(xb_ld(&bar[XB_XGEN(b.x)]) == gen, bar);
            __builtin_amdgcn_fence(__ATOMIC_ACQUIRE, "agent");
            asm volatile("s_waitcnt vmcnt(0)" ::: "memory");
        }
    }
    __syncthreads();
}

__global__ void __launch_bounds__(512, 2) mega(Args a) {
    extern __shared__ __attribute__((aligned(16))) unsigned char lds_raw[];
    LAS unsigned char* lds = (LAS unsigned char*)lds_raw;
    cg::grid_group grid = cg::this_grid();
    if (threadIdx.x < 4) ((LAS unsigned*)(lds + LDS_MISC))[threadIdx.x] = 0u;
    __syncthreads();
    unsigned* barw = (unsigned*)(a.ws + WS_BAR);
    XcdBarrier xbar; xbar.bar = barw; xbar.x = 0; xbar.st = (volatile LAS unsigned*)(lds + LDS_MISC);
    const int lo = a.ph_lo, hi = a.ph_hi;
    const int G = gridDim.x, bx = blockIdx.x;
    const int vcu = (G % 8 == 0) ? (bx % 8) * (G / 8) + bx / 8 : bx;
    unsigned char* ws = a.ws;
#define IN(k) (lo <= (k) && (k) < hi)
#define SEAM(k) do { if (IN(k) && IN((k) + 1)) xcd_barrier(xbar); } while (0)
    if (lo < 0) grid.sync();
    xbar = xcd_barrier_post(barw, (volatile LAS unsigned*)(lds + LDS_MISC));
    if (IN(0)) { REP(0) prologue(lds, a); }
    SEAM(0);
    if (IN(1)) {
        pg8::Gemm g{(const bf16_t*)(ws + WS_XB), (const bf16_t*)(ws + WS_W0T), M, 6144, 2048}; pg8::StaticOrder S; S.init(M, 6144, G, bx);
        pg8::EpiProj E{(bf16_t*)(ws + WS_P0), 6144, (const float*)(ws + WS_SSQ0), 1024, 0.125f * LOG2E};
        REP(1) pg8::gemm_phase<pg8::EpiProj, pg8::StaticOrder, true, true>(lds, g, S, E);
    }
    SEAM(1);
    if (IN(2)) {
        const bf16_t* P0 = (const bf16_t*)(ws + WS_P0);
        int prev_h = -1;
        REP(20) for (int u = vcu; u < 1024; u += G) {
            const int bh = u >> 4, qb = u & 15;
            attn_unit<64, 0>(lds, P0, 6144, 0, 1024, 2048, P0, 6144, 4096, (bf16_t*)(ws + WS_MIX), 2048, 0, bh >> 4, bh & 15, qb, a.in[3], nullptr, prev_h == (bh & 15));
            prev_h = bh & 15;
        }
        REP(21) s5_pass<false>(lds, a);
    }
    SEAM(2);
    if (IN(3)) { REP(3) s5_pass<true>(lds, a); }
    SEAM(3);
    if (IN(4)) {
        pg8::Gemm g{(const bf16_t*)(ws + WS_YG), (const bf16_t*)(ws + WS_WGT), M, 1024, 1024}; pg8::StaticOrder S; S.init(M, 1024, G, bx);
        pg8::EpiGlu E{(const bf16_t*)(ws + WS_YG), 1024, (const bf16_t*)(ws + WS_P0) + 5120, 6144, a.in[13], (bf16_t*)(ws + WS_MIX) + 1024, 2048};
        REP(4) pg8::gemm_phase<pg8::EpiGlu, pg8::StaticOrder, true, true>(lds, g, S, E);
    }
    SEAM(4);
    if (IN(5)) {
        pg8::Gemm g{(const bf16_t*)(ws + WS_MIX), (const bf16_t*)(ws + WS_WO0T), M, 2048, 2048}; pg8::StaticOrder S; S.init(M, 2048, G, bx);
        pg8::EpiRes E{nullptr, (const bf16_t*)(ws + WS_XB), nullptr, (bf16_t*)(ws + WS_XB), (float*)(ws + WS_SSQ1)};
        if (DUP == 5) { pg8::EpiRes E2{a.in[0], nullptr, nullptr, (bf16_t*)(ws + WS_XB), (float*)(ws + 262144)}; pg8::gemm_phase<pg8::EpiRes, pg8::StaticOrder, true, true>(lds, g, S, E2); }
        pg8::gemm_phase<pg8::EpiRes, pg8::StaticOrder, true, true>(lds, g, S, E);
    }
    SEAM(5);
    if (IN(6)) {
        REP(60) flogit_phase(lds, a);
        pg8::Gemm g{(const bf16_t*)(ws + WS_XB), (const bf16_t*)(ws + WS_W1T), M, 8192, 2048}; pg8::StaticOrder S; S.init(M, 8192, G, bx);
        pg8::EpiProj E{(bf16_t*)(ws + WS_P1), 8192, (const float*)(ws + WS_SSQ1), 2048, 0.08838834764831845f * LOG2E};
        REP(6) pg8::gemm_phase<pg8::EpiProj, pg8::StaticOrder, true, true>(lds, g, S, E);
    }
    SEAM(6);
    if (IN(7)) {
        const bf16_t* P1 = (const bf16_t*)(ws + WS_P1);
        REP(7) for (int pi = vcu; pi < 512; pi += G) {
            const int bh = pi >> 3, x = pi & 7;
            attn_unit<128, 1>(lds, P1, 8192, 0, 2048, 4096, P1, 8192, 6144, (bf16_t*)(ws + WS_OG), 2048, 0, bh >> 4, bh & 15, 15 - x, (const float*)(ws + WS_CUML), (const float*)(ws + WS_BTOT), false);
            attn_unit<128, 1>(lds, P1, 8192, 0, 2048, 4096, P1, 8192, 6144, (bf16_t*)(ws + WS_OG), 2048, 0, bh >> 4, bh & 15, x, (const float*)(ws + WS_CUML), (const float*)(ws + WS_BTOT), true);
        }
    }
    SEAM(7);
    if (IN(8)) {
        pg8::Gemm g{(const bf16_t*)(ws + WS_OG), (const bf16_t*)(ws + WS_WO1T), M, 2048, 2048}; pg8::PanelOrder S; S.init(M, 2048, G, bx);
        if (G % 8 == 0) {
            pg8::EpiResNorm E{(const bf16_t*)(ws + WS_XB), a.out, (float*)(ws + WS_SSQ2), (unsigned*)(ws + WS_CNT), a.in[19]};
            pg8::gemm_phase<pg8::EpiResNorm, pg8::PanelOrder, true, true>(lds, g, S, E);
        } else {
            pg8::EpiRes E{nullptr, (const bf16_t*)(ws + WS_XB), a.out, nullptr, (float*)(ws + WS_SSQ2)};
            pg8::gemm_phase<pg8::EpiRes, pg8::PanelOrder, true, true>(lds, g, S, E);
            xcd_barrier(xbar);
            final_norm(a);
        }
    }
    if (DUP == 100) { for (int q = 0; q < 9; ++q) xcd_barrier(xbar); }
#undef IN
#undef SEAM
}

extern "C" void kernel_launch(void* const* d_in, const int* in_sizes, int n_in, void* d_out, int out_size, void* d_ws, size_t ws_size, hipStream_t stream) {
    static int grid = 0;
    if (grid == 0) {
        if (n_in != 20 || out_size != M * DM || ws_size < WS_END) { fprintf(stderr, "kernel_launch: unexpected shapes (n_in %d out %d ws %zu)\n", n_in, out_size, ws_size); grid = -1; return; }
        int dev = 0, cus = 0, per_cu = 0;
        (void)hipGetDevice(&dev);
        (void)hipDeviceGetAttribute(&cus, hipDeviceAttributeMultiprocessorCount, dev);
        (void)hipFuncSetAttribute((const void*)mega, hipFuncAttributeMaxDynamicSharedMemorySize, LDS_BYTES);
        (void)hipOccupancyMaxActiveBlocksPerMultiprocessor(&per_cu, (const void*)mega, 512, LDS_BYTES);
        if (per_cu < 1) per_cu = 1;
        grid = cus * per_cu;
        (void)hipGetLastError();
    }
    if (grid < 0) return;
    Args a{};
    for (int i = 0; i < 20; ++i) a.in[i] = (const float*)d_in[i];
    a.out = (float*)d_out; a.ws = (unsigned char*)d_ws; a.ph_lo = 0; a.ph_hi = 10;
    (void)hipMemsetAsync((unsigned char*)d_ws + WS_BAR, 0, XCD_BAR_WORDS * 4, stream);
    void* args[] = {&a};
    hipError_t e = hipLaunchCooperativeKernel((const void*)mega, dim3(grid), dim3(512), args, LDS_BYTES, stream);
    if (e != hipSuccess) fprintf(stderr, "cooperative launch failed: %s (grid %d)\n", hipGetErrorString(e), grid);
}
```
